# Optimizing an MI355X kernel written in HIP

```python
import math
import jax, jax.numpy as jnp
from jax import lax
import numpy as np

D_MODEL = 1024
BATCH = 8
SEQ = 8192
DEPTH = 1

HEAD_DIM = 64
N_HEADS_A = D_MODEL // (2 * HEAD_DIM)
N_KV_HEADS_A = N_HEADS_A // 4
N_HEADS_B = D_MODEL // (2 * HEAD_DIM)
WIDTH_A = N_HEADS_A * HEAD_DIM
WIDTH_B = N_HEADS_B * HEAD_DIM
MIX_WIDTH = WIDTH_A + WIDTH_B
D_IN_PROJ = (N_HEADS_A + 2 * N_KV_HEADS_A + 3 * N_HEADS_B) * HEAD_DIM
WINDOW_A = 128
DILATED_BRANCHES = ((128, 1), (512, 4), (2048, 16))
BLOCK = 128
ROPE_THETA = 150000.0
REL_BUCKETS = 32
REL_MAX_DISTANCE = 2048
D_FF = -(-8 * D_MODEL // (3 * 256)) * 256
NORM_EPS = 1e-5

kernel_name = "hymba_swa_sink_dilated_hybrid"


def rmsnorm(x, g):
    xf = x.astype(jnp.float32)
    y = xf * lax.rsqrt(jnp.mean(xf * xf, axis=-1, keepdims=True) + NORM_EPS)
    return (y * g.astype(jnp.float32)).astype(x.dtype)


def rope(t, seq_len):
    half = t.shape[-1] // 2
    inv_freq = ROPE_THETA ** (-jnp.arange(half, dtype=jnp.float32) / half)
    ang = jnp.arange(seq_len, dtype=jnp.float32)[:, None] * inv_freq[None, :]
    cos = jnp.cos(ang)[None, :, None, :].astype(t.dtype)
    sin = jnp.sin(ang)[None, :, None, :].astype(t.dtype)
    t1, t2 = t[..., :half], t[..., half:]
    return jnp.concatenate([t1 * cos - t2 * sin, t1 * sin + t2 * cos], axis=-1)


def t5_bucket(dist):
    max_exact = REL_BUCKETS // 2
    df = jnp.maximum(dist, 1).astype(jnp.float32)
    large = max_exact + (jnp.log(df / max_exact) / math.log(REL_MAX_DISTANCE / max_exact)
                         * (REL_BUCKETS - max_exact)).astype(jnp.int32)
    large = jnp.minimum(large, REL_BUCKETS - 1)
    return jnp.where(dist < max_exact, dist, large)


def banded_attention(q, k, v, n_back, bias=None, sinks=None):
    N, H, L, D = q.shape
    Hkv = k.shape[1]
    G = H // Hkv
    nb = L // BLOCK
    qb = q.reshape(N, Hkv, G, nb, BLOCK, D) * (D ** -0.5)

    def windows(t):
        tb = t.reshape(N, Hkv, nb, BLOCK, D)
        prev = jnp.pad(tb, ((0, 0), (0, 0), (1, 0), (0, 0), (0, 0)))[:, :, :-1]
        return jnp.concatenate([prev, tb], axis=3)

    kw, vw = windows(k), windows(v)
    s = jnp.einsum('nkgbqd,nkbsd->nkgbqs', qb, kw).astype(jnp.float32)
    delta = BLOCK + jnp.arange(BLOCK)[:, None] - jnp.arange(2 * BLOCK)[None, :]
    in_band = (delta >= 0) & (delta <= n_back)
    key_exists = (jnp.arange(nb)[:, None] > 0) | (jnp.arange(2 * BLOCK)[None, :] >= BLOCK)
    mask = in_band[None] & key_exists[:, None, :]
    if bias is not None:
        b = bias.astype(jnp.float32)[:, jnp.clip(delta, 0, n_back)]
        s = s + b.reshape(1, Hkv, G, 1, BLOCK, 2 * BLOCK)
    s = jnp.where(mask, s, -jnp.inf)
    m = jnp.max(s, axis=-1)
    if sinks is not None:
        sk = sinks.astype(jnp.float32).reshape(1, Hkv, G, 1, 1)
        m = jnp.maximum(m, sk)
    p = jnp.exp(s - m[..., None])
    denom = jnp.sum(p, axis=-1)
    if sinks is not None:
        denom = denom + jnp.exp(sk - m)
    o = jnp.einsum('nkgbqs,nkbsd->nkgbqd', p, vw.astype(jnp.float32)) / denom[..., None]
    lse = m + jnp.log(denom)
    return o.reshape(N, H, L, D).astype(q.dtype), lse.reshape(N, H, L)


def sliding_window_sink_gqa(q, k, v, sinks):
    S = q.shape[1]
    q, k = rope(q, S), rope(k, S)
    o, _ = banded_attention(q.transpose(0, 2, 1, 3), k.transpose(0, 2, 1, 3),
                            v.transpose(0, 2, 1, 3), WINDOW_A - 1, sinks=sinks)
    return o.transpose(0, 2, 1, 3)


def dilated_mixture(q, k, v, rel_table):
    B, S, H, D = q.shape
    outs, lses = [], []
    for window, dil in DILATED_BRANCHES:
        n_back = window // dil
        span = dil * BLOCK
        s_pad = -(-S // span) * span
        L = s_pad // dil

        def to_sub(t):
            t = jnp.pad(t, ((0, 0), (0, s_pad - S), (0, 0), (0, 0)))
            return t.reshape(B, L, dil, H, D).transpose(0, 2, 3, 1, 4).reshape(B * dil, H, L, D)

        bias = rel_table[t5_bucket(jnp.arange(n_back + 1) * dil)].T
        o, lse = banded_attention(to_sub(q), to_sub(k), to_sub(v), n_back, bias=bias)
        o = o.reshape(B, dil, H, L, D).transpose(0, 3, 1, 2, 4).reshape(B, s_pad, H, D)[:, :S]
        lse = lse.reshape(B, dil, H, L).transpose(0, 3, 1, 2).reshape(B, s_pad, H)[:, :S]
        outs.append(o)
        lses.append(lse)
    w = jax.nn.softmax(jnp.stack(lses, axis=0), axis=0)
    out = jnp.sum(w[..., None] * jnp.stack(outs, axis=0).astype(jnp.float32), axis=0)
    return out.astype(q.dtype)


def setup_inputs(seed: int = 0) -> dict:
    key = jax.random.key(seed)
    ks = jax.random.split(key, 16)
    f32 = jnp.float32
    nrm = lambda k, shape, scale: jax.random.normal(k, shape, f32) * scale
    return {
        "x": jax.random.normal(ks[0], (BATCH, SEQ, D_MODEL), f32),
        "g_attn": 1.0 + nrm(ks[1], (DEPTH, D_MODEL), 0.01),
        "w_in": nrm(ks[2], (DEPTH, D_MODEL, D_IN_PROJ), D_MODEL ** -0.5),
        "b_in": nrm(ks[3], (DEPTH, D_IN_PROJ), 0.01),
        "sinks": nrm(ks[4], (DEPTH, N_HEADS_A), 0.5),
        "rel_table": nrm(ks[5], (REL_BUCKETS, N_HEADS_B), 0.5),
        "g_out_a": 1.0 + nrm(ks[6], (DEPTH, WIDTH_A), 0.01),
        "g_out_b": 1.0 + nrm(ks[7], (DEPTH, WIDTH_B), 0.01),
        "w_o": nrm(ks[8], (DEPTH, MIX_WIDTH, D_MODEL), MIX_WIDTH ** -0.5),
        "g_ffn": 1.0 + nrm(ks[9], (DEPTH, D_MODEL), 0.01),
        "w_gate": nrm(ks[10], (DEPTH, D_MODEL, D_FF), D_MODEL ** -0.5),
        "w_up": nrm(ks[11], (DEPTH, D_MODEL, D_FF), D_MODEL ** -0.5),
        "w_down": nrm(ks[12], (DEPTH, D_FF, D_MODEL), D_FF ** -0.5),
        "g_final": 1.0 + nrm(ks[13], (D_MODEL,), 0.01),
    }


def reference(x, g_attn, w_in, b_in, sinks, rel_table, g_out_a, g_out_b, w_o,
              g_ffn, w_gate, w_up, w_down, g_final):
    B, S, _ = x.shape
    splits = np.cumsum([WIDTH_A, N_KV_HEADS_A * HEAD_DIM, N_KV_HEADS_A * HEAD_DIM,
                        WIDTH_B, WIDTH_B])
    for l in range(DEPTH):
        h = rmsnorm(x, g_attn[l])
        proj = jnp.einsum('bsd,de->bse', h, w_in[l]) + b_in[l]
        qa, ka, va, qb, kb, vb = jnp.split(proj, splits, axis=-1)
        qa = qa.reshape(B, S, N_HEADS_A, HEAD_DIM)
        ka = ka.reshape(B, S, N_KV_HEADS_A, HEAD_DIM)
        va = va.reshape(B, S, N_KV_HEADS_A, HEAD_DIM)
        qb = qb.reshape(B, S, N_HEADS_B, HEAD_DIM)
        kb = kb.reshape(B, S, N_HEADS_B, HEAD_DIM)
        vb = vb.reshape(B, S, N_HEADS_B, HEAD_DIM)
        oa = sliding_window_sink_gqa(qa, ka, va, sinks[l]).reshape(B, S, WIDTH_A)
        ob = dilated_mixture(qb, kb, vb, rel_table).reshape(B, S, WIDTH_B)
        mixed = jnp.concatenate([rmsnorm(oa, g_out_a[l]), rmsnorm(ob, g_out_b[l])], axis=-1)
        x = x + jnp.einsum('bse,ed->bsd', mixed, w_o[l])
        h = rmsnorm(x, g_ffn[l])
        act = jax.nn.silu(jnp.einsum('bsd,df->bsf', h, w_gate[l])) * jnp.einsum('bsd,df->bsf', h, w_up[l])
        x = x + jnp.einsum('bsf,fd->bsd', act, w_down[l])
    return rmsnorm(x, g_final)
```

```cpp
#include <hip/hip_runtime.h>
#include <hip/hip_cooperative_groups.h>
#include <cstdio>
#include <cstdint>
namespace cg = cooperative_groups;
namespace pg8 {
#define PG8_LAS __attribute__((address_space(3)))
typedef unsigned short bf16_t;
typedef short bf16x8 __attribute__((ext_vector_type(8)));
typedef float f32x4 __attribute__((ext_vector_type(4)));
typedef unsigned u32x4 __attribute__((ext_vector_type(4)));
constexpr int BM = 256, BK = 64, HALF = 128, HTB = HALF * BK * 2  , STAGE_BYTES = 8 * HTB, NXCD = 8, WGM = 8;

__host__ __device__ __forceinline__ int lds_byte(int r, int c) { const int st = (r >> 4) * 2 + (c >> 5), rr = r & 15, cc = c & 31, ob = rr * 64 + cc * 2; return st * 1024 + (ob ^ (((ob >> 9) & 1) << 5)); }
__host__ __device__ __forceinline__ void stage_rc(int b, int& R, int& C) { const int st = b / 1024, sb = b % 1024, swz = sb ^ (((sb >> 9) & 1) << 5); R = (st >> 1) * 16 + swz / 64; C = (st & 1) * 32 + (swz % 64) / 2; }
__host__ __device__ __forceinline__ int perm32(int rho) { const int n = rho >> 4, i = rho & 15; return 8 * (i >> 2) + 4 * n + (i & 3); }

struct Unit { int pm, pn; };
struct Gemm { const bf16_t* A; const bf16_t* Bt; int M, N, K; };

struct StaticOrder {
    int nM, nN, nwg, G, c;
    __host__ __device__ void init(int M, int N, int G_, int c_) { nM = M / BM; nN = N / BM; nwg = nM * nN; G = G_; c = c_; }
    __host__ __device__ bool next(int i, Unit& u) const {
        const long L = (long)i * G + c; if (L >= nwg) return false;
        int wgid = (int)L; { const int q = nwg / NXCD, r = nwg % NXCD, xcd = wgid % NXCD, off = wgid / NXCD; wgid = (xcd < r ? xcd * (q + 1) : r * (q + 1) + (xcd - r) * q) + off; }
        const int nig = WGM * nN, gid = wgid / nig, fm = gid * WGM, gsz = (nM - fm) < WGM ? (nM - fm) : WGM;
        u.pm = fm + ((wgid % nig) % gsz); u.pn = (wgid % nig) / gsz; return true;
    }
    __device__ __forceinline__ void a_ready(const Unit&) const {}
    __device__ __forceinline__ void done(const Unit&) const {}
};

__device__ __forceinline__ unsigned cvt_pk_bf16(float lo, float hi) { unsigned r; asm volatile("v_cvt_pk_bf16_f32 %0, %1, %2" : "=v"(r) : "v"(lo), "v"(hi)); return r; }
typedef float f32x2 __attribute__((ext_vector_type(2)));
template <class Epi, class Sched, bool ALIGN_EPI = false, bool SP2 = false>
__device__ __forceinline__ void gemm_phase(PG8_LAS unsigned char* lds, const Gemm g, const Sched& S, const Epi& E) {
    const int tid = threadIdx.x, wid = __builtin_amdgcn_readfirstlane(tid >> 6), lane = tid & 63, wr = wid >> 2, wc = wid & 3, fr = lane & 15, fq = lane >> 4;
    const int K = g.K, nt = K / BK;
    unsigned voffA[2], voffB[2];
#pragma unroll
    for (int i = 0; i < 2; ++i) { int R, C; stage_rc(tid * 16 + i * 8192, R, C); const int Rb = Epi::PERM ? ((R & ~31) + perm32(R & 31)) : R;
        voffA[i] = (unsigned)(R * K + C) * 2u; voffB[i] = (unsigned)(Rb * K + C) * 2u; }
    const size_t kstep = (size_t)(BK * 2);
    const size_t hstep = (size_t)HALF * K * 2;
    const size_t tstep = 2 * hstep;
    const unsigned ldsw = (unsigned)wid * 1024u;
    const int aoff = lds_byte(wr * 64 + fr, fq * 8), boff = lds_byte(wc * 32 + fr, fq * 8);
#define PG8_SA(b, h) (((b) * 2 + (h)) * HTB)
#define PG8_SB(b, h) ((4 + (b) * 2 + (h)) * HTB)
#define PG8_STAGE(bufoff, gbase, voff) do { _Pragma("unroll") for (int _i = 0; _i < 2; ++_i) \
        __builtin_amdgcn_global_load_lds((const unsigned*)((const char*)(gbase) + (voff)[_i]), (PG8_LAS unsigned*)(lds + (bufoff) + ldsw + _i * 8192), 16, 0, 0); } while (0)
#define PG8_LDA(dst, b, h) do { _Pragma("unroll") for (int m = 0; m < 4; ++m) _Pragma("unroll") for (int k = 0; k < 2; ++k) dst[m][k] = *(const PG8_LAS bf16x8*)(lds + PG8_SA(b, h) + aoff + m * 2048 + k * 1024); } while (0)
#define PG8_LDB(dst, b, h) do { _Pragma("unroll") for (int n = 0; n < 2; ++n) _Pragma("unroll") for (int k = 0; k < 2; ++k) dst[n][k] = *(const PG8_LAS bf16x8*)(lds + PG8_SB(b, h) + boff + n * 2048 + k * 1024); } while (0)
#define PG8_MMA(ai, bj, At, Bt) do { __builtin_amdgcn_s_setprio(1); _Pragma("unroll") for (int m = 0; m < 4; ++m) _Pragma("unroll") for (int n = 0; n < 2; ++n) _Pragma("unroll") for (int k = 0; k < 2; ++k) \
        acc[ai][bj][m][n] = __builtin_amdgcn_mfma_f32_16x16x32_bf16(Bt[n][k], At[m][k], acc[ai][bj][m][n], 0, 0, 0); __builtin_amdgcn_s_setprio(0); } while (0)
#define PG8_WAIT_V(n) asm volatile("s_waitcnt vmcnt(" #n ")" ::: "memory")
#define PG8_WAIT_L(n) asm volatile("s_waitcnt lgkmcnt(" #n ")" ::: "memory")
#define PG8_BAR __builtin_amdgcn_s_barrier()
#define PG8_SCHED __builtin_amdgcn_sched_barrier(0)
    Unit cur, nxt; int ui = 0;
    if (!S.next(0, cur)) return;
    f32x4 acc[2][2][4][2];
#pragma unroll
    for (int a = 0; a < 2; ++a)
#pragma unroll
        for (int b = 0; b < 2; ++b)
#pragma unroll
            for (int m = 0; m < 4; ++m)
#pragma unroll
                for (int n = 0; n < 2; ++n) acc[a][b][m][n] = (f32x4){0.f, 0.f, 0.f, 0.f};
    bf16x8 At[4][2], B0[2][2], B1[2][2];
    const char* cA = (const char*)g.A + (size_t)cur.pm * tstep; const char* cB = (const char*)g.Bt + (size_t)cur.pn * tstep;
    S.a_ready(cur);
    if constexpr (SP2) {
        PG8_STAGE(PG8_SB(0, 0), cB, voffB); PG8_STAGE(PG8_SB(0, 1), cB + hstep, voffB); PG8_STAGE(PG8_SA(0, 0), cA, voffA); PG8_STAGE(PG8_SA(0, 1), cA + hstep, voffA);
        if (wr == 1) PG8_BAR;
        PG8_WAIT_V(2); PG8_BAR;
        PG8_STAGE(PG8_SB(1, 0), cB + kstep, voffB); PG8_STAGE(PG8_SA(1, 0), cA + kstep, voffA); PG8_STAGE(PG8_SB(1, 1), cB + hstep + kstep, voffB);
        PG8_WAIT_V(6); PG8_BAR;
    } else {
        PG8_STAGE(PG8_SB(0, 0), cB, voffB); PG8_STAGE(PG8_SA(0, 0), cA, voffA); PG8_STAGE(PG8_SB(0, 1), cB + hstep, voffB); PG8_STAGE(PG8_SA(0, 1), cA + hstep, voffA);
        if (wr == 1) PG8_BAR;
        PG8_WAIT_V(4); PG8_BAR;
        PG8_STAGE(PG8_SB(1, 0), cB + kstep, voffB); PG8_STAGE(PG8_SA(1, 0), cA + kstep, voffA); PG8_STAGE(PG8_SB(1, 1), cB + hstep + kstep, voffB);
        PG8_WAIT_V(6); PG8_BAR;
    }
    for (;;) {
        const bool has_next = S.next(ui + 1, nxt);
        const char* nA = has_next ? (const char*)g.A + (size_t)nxt.pm * tstep : cA; const char* nB = has_next ? (const char*)g.Bt + (size_t)nxt.pn * tstep : cB;
        for (int t = 0; t < nt; t += 2) {
            const bool last = (t == nt - 2);
            const char* a1 = cA + (size_t)(t + 1) * kstep;
            const char* a2 = last ? nA : cA + (size_t)(t + 2) * kstep; const char* b2 = last ? nB : cB + (size_t)(t + 2) * kstep;
            const char* a3 = a2 + kstep; const char* b3 = b2 + kstep;
            if (last && has_next) S.a_ready(nxt);
            if constexpr (SP2) {
            PG8_LDB(B0, 0, 0); PG8_LDB(B1, 0, 1); PG8_SCHED; PG8_LDA(At, 0, 0); PG8_STAGE(PG8_SA(1, 1), a1 + hstep, voffA);
            PG8_WAIT_V(8); PG8_WAIT_L(0); PG8_BAR; PG8_MMA(0, 0, At, B0); PG8_MMA(0, 1, At, B1); PG8_BAR; PG8_SCHED;
            PG8_LDA(At, 0, 1); PG8_STAGE(PG8_SB(0, 0), b2, voffB); PG8_STAGE(PG8_SB(0, 1), b2 + hstep, voffB); PG8_STAGE(PG8_SA(0, 0), a2, voffA);
            PG8_WAIT_V(8); PG8_WAIT_L(0); PG8_BAR; PG8_MMA(1, 0, At, B0); PG8_MMA(1, 1, At, B1); PG8_BAR; PG8_SCHED;
            PG8_LDB(B0, 1, 0); PG8_LDB(B1, 1, 1); PG8_SCHED; PG8_LDA(At, 1, 0); PG8_STAGE(PG8_SA(0, 1), a2 + hstep, voffA);
            PG8_WAIT_V(8); PG8_WAIT_L(0); PG8_BAR; PG8_MMA(0, 0, At, B0); PG8_MMA(0, 1, At, B1); PG8_BAR; PG8_SCHED;
            PG8_LDA(At, 1, 1); PG8_STAGE(PG8_SB(1, 0), b3, voffB); PG8_STAGE(PG8_SB(1, 1), b3 + hstep, voffB); PG8_STAGE(PG8_SA(1, 0), a3, voffA);
            PG8_WAIT_V(8); PG8_WAIT_L(0); PG8_BAR; PG8_MMA(1, 0, At, B0); PG8_MMA(1, 1, At, B1); PG8_BAR; PG8_SCHED;
            } else {
            PG8_LDB(B0, 0, 0); PG8_SCHED; PG8_LDA(At, 0, 0); PG8_STAGE(PG8_SA(1, 1), a1 + hstep, voffA);
            PG8_WAIT_L(8); PG8_BAR; PG8_WAIT_L(0); PG8_MMA(0, 0, At, B0); PG8_BAR; PG8_SCHED;
            PG8_LDB(B1, 0, 1); PG8_STAGE(PG8_SB(0, 0), b2, voffB);
            PG8_BAR; PG8_WAIT_L(0); PG8_MMA(0, 1, At, B1); PG8_BAR;
            PG8_LDA(At, 0, 1); PG8_STAGE(PG8_SA(0, 0), a2, voffA);
            PG8_BAR; PG8_WAIT_L(0); PG8_MMA(1, 0, At, B0); PG8_BAR; PG8_SCHED;
            PG8_STAGE(PG8_SB(0, 1), b2 + hstep, voffB);
            PG8_WAIT_V(6); PG8_BAR; PG8_MMA(1, 1, At, B1); PG8_BAR;
            PG8_LDB(B0, 1, 0); PG8_SCHED; PG8_LDA(At, 1, 0); PG8_STAGE(PG8_SA(0, 1), a2 + hstep, voffA);
            PG8_WAIT_L(8); PG8_BAR; PG8_WAIT_L(0); PG8_MMA(0, 0, At, B0); PG8_BAR; PG8_SCHED;
            PG8_LDB(B1, 1, 1); PG8_STAGE(PG8_SB(1, 0), b3, voffB);
            PG8_BAR; PG8_WAIT_L(0); PG8_MMA(0, 1, At, B1); PG8_BAR;
            PG8_LDA(At, 1, 1); PG8_STAGE(PG8_SA(1, 0), a3, voffA);
            PG8_BAR; PG8_WAIT_L(0); PG8_MMA(1, 0, At, B0); PG8_BAR; PG8_SCHED;
            PG8_STAGE(PG8_SB(1, 1), b3 + hstep, voffB);
            PG8_WAIT_V(6); PG8_BAR; PG8_MMA(1, 1, At, B1); PG8_BAR;
            }
        }
        if constexpr (ALIGN_EPI) { if (wr == 0) PG8_BAR; }
        if constexpr (!Epi::AFTER_DRAIN) { E(acc, cur, wr, wc, fr, fq); S.done(cur); }
        if (!has_next) break;
#pragma unroll
        for (int a = 0; a < 2; ++a)
#pragma unroll
            for (int b = 0; b < 2; ++b)
#pragma unroll
                for (int m = 0; m < 4; ++m)
#pragma unroll
                    for (int n = 0; n < 2; ++n) acc[a][b][m][n] = (f32x4){0.f, 0.f, 0.f, 0.f};
        cur = nxt; cA = nA; cB = nB; ++ui;
        if constexpr (ALIGN_EPI) { if (wr == 1) PG8_BAR; }
    }
    PG8_WAIT_V(0);
    if constexpr (!ALIGN_EPI) { if (wr == 0) PG8_BAR; }
    PG8_BAR;
    if constexpr (Epi::AFTER_DRAIN) { E.fused(acc, cur, wr, wc, fr, fq, lds, wid, lane); S.done(cur); }
#undef PG8_SA
#undef PG8_SB
#undef PG8_STAGE
#undef PG8_LDA
#undef PG8_LDB
#undef PG8_MMA
#undef PG8_WAIT_V
#undef PG8_WAIT_L
#undef PG8_BAR
#undef PG8_SCHED
}
}
namespace pg8 {
typedef unsigned u32x2 __attribute__((ext_vector_type(2)));
constexpr int LD_QKV = 2304, LD_D = 1024, LD_FF = 2816;
constexpr float RMS_EPS = 1e-5f;

struct EpiQKV {
    static constexpr bool PERM = true, AFTER_DRAIN = false;
    bf16_t* O; const float* bias;
    __device__ __forceinline__ void operator()(const f32x4 (&acc)[2][2][4][2], const Unit& u, int wr, int wc, int fr, int fq) const {
        const int row0 = u.pm * BM + wr * 64 + fr, col0 = u.pn * BM + wc * 32 + 8 * fq;
        const float sc = (u.pn < 2 || u.pn == 3 || u.pn == 4) ? 0.125f : 1.0f;
        f32x4 bv[2][2];
#pragma unroll
        for (int bj = 0; bj < 2; ++bj)
#pragma unroll
            for (int n = 0; n < 2; ++n) bv[bj][n] = *(const f32x4*)(bias + col0 + bj * HALF + 4 * n);
#pragma unroll
        for (int ai = 0; ai < 2; ++ai)
#pragma unroll
            for (int m = 0; m < 4; ++m) { bf16_t* rowp = O + (size_t)(row0 + ai * HALF + m * 16) * LD_QKV + col0;
#pragma unroll
                for (int bj = 0; bj < 2; ++bj) { f32x4 v0 = (acc[ai][bj][m][0] + bv[bj][0]) * sc, v1 = (acc[ai][bj][m][1] + bv[bj][1]) * sc;
                    u32x4 w; w.x = cvt_pk_bf16(v0[0], v0[1]); w.y = cvt_pk_bf16(v0[2], v0[3]); w.z = cvt_pk_bf16(v1[0], v1[1]); w.w = cvt_pk_bf16(v1[2], v1[3]);
                    *(u32x4*)(rowp + bj * HALF) = w; } }
    }
};
struct EpiRes1 {
    static constexpr bool PERM = false, AFTER_DRAIN = false;
    const float* X; float* X1; bf16_t* X1B; float* ssq;
    __device__ __forceinline__ void operator()(const f32x4 (&acc)[2][2][4][2], const Unit& u, int wr, int wc, int fr, int fq) const {
        const int row0 = u.pm * BM + wr * 64 + fr, col0 = u.pn * BM + wc * 32 + 4 * fq;
#pragma unroll
        for (int ai = 0; ai < 2; ++ai)
#pragma unroll
            for (int m = 0; m < 4; ++m) { const int r = row0 + ai * HALF + m * 16; const size_t off = (size_t)r * LD_D + col0; float ss = 0.f;
#pragma unroll
                for (int bj = 0; bj < 2; ++bj)
#pragma unroll
                    for (int n = 0; n < 2; ++n) { const f32x4 xv = *(const f32x4*)(X + off + bj * HALF + n * 16); const f32x4 o = xv + acc[ai][bj][m][n];
                        *(f32x4*)(X1 + off + bj * HALF + n * 16) = o; u32x2 w; w.x = cvt_pk_bf16(o[0], o[1]); w.y = cvt_pk_bf16(o[2], o[3]);
                        *(u32x2*)(X1B + off + bj * HALF + n * 16) = w; ss += (o[0] * o[0] + o[1] * o[1]) + (o[2] * o[2] + o[3] * o[3]); }
                ss += __shfl_xor(ss, 16); ss += __shfl_xor(ss, 32);
                if (fq == 0) atomicAdd(ssq + r, ss);
                if (m & 1) asm volatile("" ::: "memory"); }
    }
};
struct EpiSwiGLU {
    static constexpr bool PERM = true, AFTER_DRAIN = false;
    bf16_t* ACT; const float* ssq;
    __device__ __forceinline__ void operator()(const f32x4 (&acc)[2][2][4][2], const Unit& u, int wr, int wc, int fr, int fq) const {
        const int row0 = u.pm * BM + wr * 64 + fr, col0 = u.pn * HALF + wc * 32 + 8 * fq;
#pragma unroll
        for (int ai = 0; ai < 2; ++ai)
#pragma unroll
            for (int m = 0; m < 4; ++m) { const int r = row0 + ai * HALF + m * 16;
                const float rs = 1.0f / sqrtf(ssq[r] * (1.0f / 1024.0f) + RMS_EPS);
                float a[8];
#pragma unroll
                for (int n = 0; n < 2; ++n)
#pragma unroll
                    for (int e = 0; e < 4; ++e) { const float g = acc[ai][0][m][n][e] * rs, up = acc[ai][1][m][n][e] * rs;
                        const float sg = g * __builtin_amdgcn_rcpf(1.0f + __builtin_amdgcn_exp2f(-1.4426950408889634f * g)); a[n * 4 + e] = sg * up; }
                u32x4 w; w.x = cvt_pk_bf16(a[0], a[1]); w.y = cvt_pk_bf16(a[2], a[3]); w.z = cvt_pk_bf16(a[4], a[5]); w.w = cvt_pk_bf16(a[6], a[7]);
                *(u32x4*)(ACT + (size_t)r * LD_FF + col0) = w; }
    }
};
struct EpiRes2 {
    static constexpr bool PERM = false, AFTER_DRAIN = false;
    float* X1;
    __device__ __forceinline__ void operator()(const f32x4 (&acc)[2][2][4][2], const Unit& u, int wr, int wc, int fr, int fq) const {
        const int row0 = u.pm * BM + wr * 64 + fr, col0 = u.pn * BM + wc * 32 + 4 * fq;
#pragma unroll
        for (int ai = 0; ai < 2; ++ai)
#pragma unroll
            for (int m = 0; m < 4; ++m) { const size_t off = (size_t)(row0 + ai * HALF + m * 16) * LD_D + col0;
#pragma unroll
                for (int bj = 0; bj < 2; ++bj)
#pragma unroll
                    for (int n = 0; n < 2; ++n) { float* p = X1 + off + bj * HALF + n * 16; const f32x4 xv = *(const f32x4*)p; *(f32x4*)p = xv + acc[ai][bj][m][n]; }
                if (m & 1) asm volatile("" ::: "memory"); }
    }
};
}
#define GAS __attribute__((address_space(1)))
#define LAS __attribute__((address_space(3)))
typedef unsigned short bf16;
typedef unsigned v4u __attribute__((ext_vector_type(4)));
typedef float f32x4 __attribute__((ext_vector_type(4)));
constexpr int BATCH = 8, SEQ = 8192, DM = 1024, M = BATCH * SEQ, NP = 2304, FF = 2816, NGU = 2 * FF;
constexpr float EPS = 1e-5f;
constexpr size_t MiB = 1u << 20;
constexpr size_t WS_SSQ1 = 0, WS_BIAS = 512 * 1024, WS_ROPE = 1 * MiB;
constexpr size_t WS_W1 = 4 * MiB, WS_W2 = 9 * MiB, WS_W3 = 11 * MiB, WS_W4 = 22 * MiB;
constexpr size_t WS_XN = 32 * MiB;
constexpr size_t WS_QKV = 160 * MiB;
constexpr size_t WS_OA = 448 * MiB, WS_OB = 512 * MiB;
constexpr size_t WS_LSE = 704 * MiB;
constexpr size_t WS_X1B = 160 * MiB;
constexpr size_t WS_ACT = 288 * MiB;
constexpr size_t WS_END = 712 * MiB;
constexpr int BIAS_LD = 132;
constexpr int LDS_BYTES = 147456;

__device__ __forceinline__ unsigned pk2(float lo, float hi) { return pg8::cvt_pk_bf16(lo, hi); }
__device__ __forceinline__ float bflo(unsigned w) { return __uint_as_float(w << 16); }
__device__ __forceinline__ float bfhi(unsigned w) { return __uint_as_float(w & 0xffff0000u); }
__device__ __forceinline__ float wave_sum(float v) {
#pragma unroll
    for (int o = 1; o < 64; o <<= 1) v += __shfl_xor(v, o);
    return v;
}
__device__ __forceinline__ void tr_item(const float* W, int K, int N, int k0, int n0, bf16* WT, int r0, LAS float* scr, int lane, const float* gk) {
#pragma unroll 8
    for (int i = 0; i < 32; ++i) { const int kk = 2 * i + (lane >> 5); float v = W[(size_t)(k0 + kk) * N + n0 + (lane & 31)]; if (gk) v *= gk[k0 + kk]; scr[kk * 33 + (lane & 31)] = v; }
    asm volatile("s_waitcnt lgkmcnt(0)" ::: "memory");
    const int c = lane & 7;
#pragma unroll
    for (int j = 0; j < 4; ++j) { const int n = (lane >> 3) + 8 * j; const LAS float* s = scr + (8 * c) * 33 + n;
        v4u o; o.x = pk2(s[0 * 33], s[1 * 33]); o.y = pk2(s[2 * 33], s[3 * 33]); o.z = pk2(s[4 * 33], s[5 * 33]); o.w = pk2(s[6 * 33], s[7 * 33]);
        *(v4u*)(WT + (size_t)(r0 + n) * K + k0 + 8 * c) = o; }
    asm volatile("s_waitcnt lgkmcnt(0)" ::: "memory");
}
__device__ __forceinline__ int t5_bucket(int dist) {
    if (dist < 16) return dist;
    const float df = (float)dist;
    int large = 16 + (int)((logf(df / 16.0f) / 4.852030263919617f) * 16.0f);
    return large < 31 ? large : 31;
}

struct Args { const float* in[14]; float* out; unsigned char* ws; };

__device__ __forceinline__ void naive_attn(const bf16* QKV, bf16* OA, bf16* OB, float* LSE, const float* sinks, const float* biasT, int gt, int NGT) {
    for (int it = gt; it < 4 * 8 * M; it += NGT) {
        const int m = it & (M - 1), ch = it >> 16, c = ch >> 3, h = ch & 7, pos = m & (SEQ - 1);
        int qcol, kcol, vcol, dil, nb;
        if (c == 0) { qcol = h * 64; kcol = 512 + (h >> 2) * 64; vcol = 640 + (h >> 2) * 64; dil = 1; nb = 127; }
        else { qcol = 768 + h * 64; kcol = 1280 + h * 64; vcol = 1792 + h * 64; dil = (c == 1) ? 1 : (c == 2 ? 4 : 16); nb = 128; }
        float q[64], o[64];
        { const v4u* qp = (const v4u*)(QKV + (size_t)m * NP + qcol);
#pragma unroll
          for (int j = 0; j < 8; ++j) { const v4u w = qp[j]; q[8*j+0] = bflo(w.x); q[8*j+1] = bfhi(w.x); q[8*j+2] = bflo(w.y); q[8*j+3] = bfhi(w.y); q[8*j+4] = bflo(w.z); q[8*j+5] = bfhi(w.z); q[8*j+6] = bflo(w.w); q[8*j+7] = bfhi(w.w); } }
#pragma unroll
        for (int j = 0; j < 64; ++j) o[j] = 0.f;
        float mx = (c == 0) ? sinks[h] : -1e30f, l = (c == 0) ? 1.f : 0.f;
        const float* bt = biasT + ((c > 0 ? c - 1 : 0) * 8 + h) * BIAS_LD;
        for (int d = 0; d <= nb; ++d) {
            const int kp = pos - d * dil; if (kp < 0) break;
            const bf16* row = QKV + (size_t)(m - d * dil) * NP;
            const v4u* kr = (const v4u*)(row + kcol); float s = 0.f;
#pragma unroll
            for (int j = 0; j < 8; ++j) { const v4u w = kr[j];
                s += q[8*j+0] * bflo(w.x) + q[8*j+1] * bfhi(w.x) + q[8*j+2] * bflo(w.y) + q[8*j+3] * bfhi(w.y) + q[8*j+4] * bflo(w.z) + q[8*j+5] * bfhi(w.z) + q[8*j+6] * bflo(w.w) + q[8*j+7] * bfhi(w.w); }
            if (c) s += bt[d];
            const float mn = fmaxf(mx, s), al = __expf(mx - mn), p = __expf(s - mn);
            l = l * al + p; mx = mn;
            const v4u* vr = (const v4u*)(row + vcol);
#pragma unroll
            for (int j = 0; j < 8; ++j) { const v4u w = vr[j];
                o[8*j+0] = o[8*j+0] * al + p * bflo(w.x); o[8*j+1] = o[8*j+1] * al + p * bfhi(w.x); o[8*j+2] = o[8*j+2] * al + p * bflo(w.y); o[8*j+3] = o[8*j+3] * al + p * bfhi(w.y);
                o[8*j+4] = o[8*j+4] * al + p * bflo(w.z); o[8*j+5] = o[8*j+5] * al + p * bfhi(w.z); o[8*j+6] = o[8*j+6] * al + p * bflo(w.w); o[8*j+7] = o[8*j+7] * al + p * bfhi(w.w); }
        }
        const float inv = 1.0f / l;
        bf16* op = (c == 0) ? (OA + (size_t)m * 512 + h * 64) : (OB + (size_t)(c - 1) * M * 512 + (size_t)m * 512 + h * 64);
#pragma unroll
        for (int j = 0; j < 8; ++j) { v4u w; w.x = pk2(o[8*j+0] * inv, o[8*j+1] * inv); w.y = pk2(o[8*j+2] * inv, o[8*j+3] * inv); w.z = pk2(o[8*j+4] * inv, o[8*j+5] * inv); w.w = pk2(o[8*j+6] * inv, o[8*j+7] * inv); ((v4u*)op)[j] = w; }
        if (c) LSE[(size_t)(c - 1) * M * 8 + (size_t)m * 8 + h] = mx + logf(l);
    }
}

__global__ void __launch_bounds__(512, 2) hymba_fwd(Args a) {
    extern __shared__ __attribute__((aligned(16))) unsigned char lds[];
    cg::grid_group grid = cg::this_grid();
    const int tid = threadIdx.x, lane = tid & 63, wave = __builtin_amdgcn_readfirstlane(tid >> 6);
    const int G = gridDim.x, bid = blockIdx.x;
    const int gw = bid * 8 + wave, NGW = G * 8, gt = bid * 512 + tid, NGT = G * 512;
    unsigned char* ws = a.ws;
    const float* x = a.in[0]; const float* g_attn = a.in[1]; const float* w_in = a.in[2]; const float* b_in = a.in[3]; const float* sinks = a.in[4];
    const float* rel_table = a.in[5]; const float* g_out_a = a.in[6]; const float* g_out_b = a.in[7]; const float* w_o = a.in[8]; const float* g_ffn = a.in[9];
    const float* w_gate = a.in[10]; const float* w_up = a.in[11]; const float* w_down = a.in[12]; const float* g_final = a.in[13];
    float* out = a.out;
    float* ssq1 = (float*)(ws + WS_SSQ1); float* biasT = (float*)(ws + WS_BIAS); float* ropeC = (float*)(ws + WS_ROPE); float* ropeS = ropeC + SEQ * 32;
    bf16* W1t = (bf16*)(ws + WS_W1); bf16* W2t = (bf16*)(ws + WS_W2); bf16* W3t = (bf16*)(ws + WS_W3); bf16* W4t = (bf16*)(ws + WS_W4);
    bf16* XN = (bf16*)(ws + WS_XN); bf16* QKV = (bf16*)(ws + WS_QKV); bf16* OA = (bf16*)(ws + WS_OA); bf16* OB = (bf16*)(ws + WS_OB);
    float* LSE = (float*)(ws + WS_LSE); bf16* X1B = (bf16*)(ws + WS_X1B); bf16* ACT = (bf16*)(ws + WS_ACT);
    LAS unsigned char* ldsl = (LAS unsigned char*)lds;

    {
        LAS float* scr = (LAS float*)(ldsl + wave * 16384);
        constexpr int I1 = 16 * 72, I2 = 16 * 32, I3 = 16 * 88, I4 = 44 * 32, NIT = I1 + I2 + 2 * I3 + I4;
        for (int it = gw; it < NIT; it += NGW) {
            int r = it;
            if (r < I1) { const int kb = r / 72, nb = r % 72; tr_item(w_in, DM, NP, 64 * kb, 32 * nb, W1t, 32 * nb, scr, lane, nullptr); continue; } r -= I1;
            if (r < I2) { const int kb = r / 32, nb = r % 32; tr_item(w_o, DM, DM, 64 * kb, 32 * nb, W2t, 32 * nb, scr, lane, nullptr); continue; } r -= I2;
            if (r < I3) { const int kb = r / 88, nb = r % 88, n0 = 32 * nb; tr_item(w_gate, DM, FF, 64 * kb, n0, W3t, 256 * (n0 >> 7) + (n0 & 127), scr, lane, g_ffn); continue; } r -= I3;
            if (r < I3) { const int kb = r / 88, nb = r % 88, n0 = 32 * nb; tr_item(w_up, DM, FF, 64 * kb, n0, W3t, 256 * (n0 >> 7) + 128 + (n0 & 127), scr, lane, g_ffn); continue; } r -= I3;
            { const int kb = r / 32, nb = r % 32; tr_item(w_down, FF, DM, 64 * kb, 32 * nb, W4t, 32 * nb, scr, lane, nullptr); }
        }
        for (int m = gw; m < M; m += NGW) {
            const f32x4* xr = (const f32x4*)(x + (size_t)m * DM) + lane; f32x4 v[4]; float s = 0.f;
#pragma unroll
            for (int j = 0; j < 4; ++j) { v[j] = xr[64 * j]; s += (v[j].x * v[j].x + v[j].y * v[j].y) + (v[j].z * v[j].z + v[j].w * v[j].w); }
            const float rs = 1.0f / sqrtf(wave_sum(s) * (1.0f / DM) + EPS);
            unsigned long long* o8 = (unsigned long long*)(XN + (size_t)m * DM) + lane;
#pragma unroll
            for (int j = 0; j < 4; ++j) { const f32x4 g = ((const f32x4*)g_attn)[lane + 64 * j];
                o8[64 * j] = (unsigned long long)pk2(v[j].x * rs * g.x, v[j].y * rs * g.y) | ((unsigned long long)pk2(v[j].z * rs * g.z, v[j].w * rs * g.w) << 32); }
        }
        for (int i = gt; i < SEQ * 32; i += NGT) { const int pos = i >> 5, f = i & 31;
            const float inv_freq = (float)exp2(-(double)f * (17.194602975157967 / 32.0));
            const float ang = (float)pos * inv_freq;
            double rev = (double)ang * 0.15915494309189535; rev -= rint(rev);
            ropeC[i] = __builtin_amdgcn_cosf((float)rev); ropeS[i] = __builtin_amdgcn_sinf((float)rev); }
        for (int i = gt; i < 3 * 8 * 129; i += NGT) { const int d = i % 129, bh = i / 129, h = bh & 7, br = bh >> 3; const int dil = br == 0 ? 1 : (br == 1 ? 4 : 16);
            biasT[bh * BIAS_LD + d] = rel_table[t5_bucket(d * dil) * 8 + h]; }
        for (int i = gt; i < M; i += NGT) ssq1[i] = 0.f;
    }
    grid.sync();
    { pg8::Gemm g{XN, W1t, M, NP, DM}; pg8::StaticOrder S; S.init(M, NP, G, bid); pg8::EpiQKV E{QKV, b_in};
      pg8::gemm_phase<pg8::EpiQKV, pg8::StaticOrder, true, true>(ldsl, g, S, E); }
    grid.sync();
    for (int i = gt; i < M * 320; i += NGT) { const int f = i & 31, hh = (i >> 5) % 10, m = i / 320, pos = m & (SEQ - 1);
        const int col = hh < 8 ? hh * 64 : 512 + (hh - 8) * 64; bf16* p = QKV + (size_t)m * NP + col + f;
        const float t1 = __uint_as_float((unsigned)p[0] << 16), t2 = __uint_as_float((unsigned)p[32] << 16), c = ropeC[pos * 32 + f], s = ropeS[pos * 32 + f];
        const unsigned w = pk2(t1 * c - t2 * s, t1 * s + t2 * c); p[0] = (bf16)(w & 0xffffu); p[32] = (bf16)(w >> 16); }
    grid.sync();
    naive_attn(QKV, OA, OB, LSE, sinks, biasT, gt, NGT);
    grid.sync();
    for (int m = gw; m < M; m += NGW) {
        float v[16];
        if (lane < 32) { const v4u* p = (const v4u*)(OA + (size_t)m * 512 + lane * 16);
#pragma unroll
            for (int j = 0; j < 2; ++j) { const v4u w = p[j]; v[8*j+0] = bflo(w.x); v[8*j+1] = bfhi(w.x); v[8*j+2] = bflo(w.y); v[8*j+3] = bfhi(w.y); v[8*j+4] = bflo(w.z); v[8*j+5] = bfhi(w.z); v[8*j+6] = bflo(w.w); v[8*j+7] = bfhi(w.w); }
        } else { const int cb = (lane - 32) * 16, h = cb >> 6;
            const float l1 = LSE[(size_t)m * 8 + h], l2 = LSE[(size_t)M * 8 + (size_t)m * 8 + h], l3 = LSE[(size_t)2 * M * 8 + (size_t)m * 8 + h];
            const float mxl = fmaxf(l1, fmaxf(l2, l3)); float w1 = __expf(l1 - mxl), w2 = __expf(l2 - mxl), w3 = __expf(l3 - mxl); const float wi = 1.0f / (w1 + w2 + w3); w1 *= wi; w2 *= wi; w3 *= wi;
#pragma unroll
            for (int j = 0; j < 16; ++j) v[j] = 0.f;
#pragma unroll
            for (int br = 0; br < 3; ++br) { const float wb = br == 0 ? w1 : (br == 1 ? w2 : w3); const v4u* p = (const v4u*)(OB + (size_t)br * M * 512 + (size_t)m * 512 + cb);
#pragma unroll
                for (int j = 0; j < 2; ++j) { const v4u w = p[j]; v[8*j+0] += wb * bflo(w.x); v[8*j+1] += wb * bfhi(w.x); v[8*j+2] += wb * bflo(w.y); v[8*j+3] += wb * bfhi(w.y); v[8*j+4] += wb * bflo(w.z); v[8*j+5] += wb * bfhi(w.z); v[8*j+6] += wb * bflo(w.w); v[8*j+7] += wb * bfhi(w.w); } }
        }
        float ss = 0.f;
#pragma unroll
        for (int j = 0; j < 16; ++j) ss += v[j] * v[j];
#pragma unroll
        for (int o = 1; o < 32; o <<= 1) ss += __shfl_xor(ss, o);
        const float rs = 1.0f / sqrtf(ss * (1.0f / 512.0f) + EPS);
        const float* gp = (lane < 32) ? (g_out_a + lane * 16) : (g_out_b + (lane - 32) * 16);
        v4u w0, w1v;
        w0.x = pk2(v[0] * rs * gp[0], v[1] * rs * gp[1]); w0.y = pk2(v[2] * rs * gp[2], v[3] * rs * gp[3]); w0.z = pk2(v[4] * rs * gp[4], v[5] * rs * gp[5]); w0.w = pk2(v[6] * rs * gp[6], v[7] * rs * gp[7]);
        w1v.x = pk2(v[8] * rs * gp[8], v[9] * rs * gp[9]); w1v.y = pk2(v[10] * rs * gp[10], v[11] * rs * gp[11]); w1v.z = pk2(v[12] * rs * gp[12], v[13] * rs * gp[13]); w1v.w = pk2(v[14] * rs * gp[14], v[15] * rs * gp[15]);
        v4u* op = (v4u*)(XN + (size_t)m * DM + lane * 16); op[0] = w0; op[1] = w1v;
    }
    grid.sync();
    { pg8::Gemm g{XN, W2t, M, DM, DM}; pg8::StaticOrder S; S.init(M, DM, G, bid); pg8::EpiRes1 E{x, out, X1B, ssq1};
      pg8::gemm_phase<pg8::EpiRes1, pg8::StaticOrder, true, true>(ldsl, g, S, E); }
    grid.sync();
    { pg8::Gemm g{X1B, W3t, M, NGU, DM}; pg8::StaticOrder S; S.init(M, NGU, G, bid); pg8::EpiSwiGLU E{ACT, ssq1};
      pg8::gemm_phase<pg8::EpiSwiGLU, pg8::StaticOrder, true, true>(ldsl, g, S, E); }
    grid.sync();
    { pg8::Gemm g{ACT, W4t, M, DM, FF}; pg8::StaticOrder S; S.init(M, DM, G, bid); pg8::EpiRes2 E{out};
      pg8::gemm_phase<pg8::EpiRes2, pg8::StaticOrder, true, true>(ldsl, g, S, E); }
    grid.sync();
    for (int m = gw; m < M; m += NGW) {
        f32x4* xr = (f32x4*)(out + (size_t)m * DM) + lane; f32x4 v[4]; float s = 0.f;
#pragma unroll
        for (int j = 0; j < 4; ++j) { v[j] = xr[64 * j]; s += (v[j].x * v[j].x + v[j].y * v[j].y) + (v[j].z * v[j].z + v[j].w * v[j].w); }
        const float rs = 1.0f / sqrtf(wave_sum(s) * (1.0f / DM) + EPS);
#pragma unroll
        for (int j = 0; j < 4; ++j) { const f32x4 g = ((const f32x4*)g_final)[lane + 64 * j]; xr[64 * j] = v[j] * rs * g; }
    }
}

extern "C" void kernel_launch(void* const* d_in, const int* in_sizes, int n_in, void* d_out, int out_size, void* d_ws, size_t ws_size, hipStream_t stream) {
    static int grid = 0;
    if (grid == 0) {
        if (n_in != 14 || out_size != M * DM || ws_size < WS_END) { fprintf(stderr, "kernel_launch: unexpected shapes (n_in %d out %d ws %zu)\n", n_in, out_size, ws_size); grid = -1; return; }
        int dev = 0, cus = 0, per_cu = 0;
        hipGetDevice(&dev); hipDeviceGetAttribute(&cus, hipDeviceAttributeMultiprocessorCount, dev);
        hipFuncSetAttribute((const void*)hymba_fwd, hipFuncAttributeMaxDynamicSharedMemorySize, LDS_BYTES);
        hipOccupancyMaxActiveBlocksPerMultiprocessor(&per_cu, (const void*)hymba_fwd, 512, LDS_BYTES);
        if (per_cu < 1) { fprintf(stderr, "kernel_launch: occupancy query says %d blocks per CU\n", per_cu); per_cu = 1; }
        (void)hipGetLastError();
        grid = cus * 1;
    }
    if (grid < 0) return;
    Args a{};
    for (int i = 0; i < 14; ++i) a.in[i] = (const float*)d_in[i];
    a.out = (float*)d_out; a.ws = (unsigned char*)d_ws;
    void* args[] = {&a};
    hipError_t e = hipLaunchCooperativeKernel((const void*)hymba_fwd, dim3(grid), dim3(512), args, LDS_BYTES, stream);
    if (e != hipSuccess) fprintf(stderr, "cooperative launch failed: %s (grid %d)\n", hipGetErrorString(e), grid);
}
```

```cpp
#include <hip/hip_runtime.h>
#include <hip/hip_cooperative_groups.h>
#include <cstdio>
#include <cstdint>
namespace cg = cooperative_groups;
namespace pg8 {
#define PG8_LAS __attribute__((address_space(3)))
typedef unsigned short bf16_t;
typedef short bf16x8 __attribute__((ext_vector_type(8)));
typedef float f32x4 __attribute__((ext_vector_type(4)));
typedef unsigned u32x4 __attribute__((ext_vector_type(4)));
constexpr int BM = 256, BK = 64, HALF = 128, HTB = HALF * BK * 2  , STAGE_BYTES = 8 * HTB, NXCD = 8, WGM = 8;

__host__ __device__ __forceinline__ int lds_byte(int r, int c) { const int st = (r >> 4) * 2 + (c >> 5), rr = r & 15, cc = c & 31, ob = rr * 64 + cc * 2; return st * 1024 + (ob ^ (((ob >> 9) & 1) << 5)); }
__host__ __device__ __forceinline__ void stage_rc(int b, int& R, int& C) { const int st = b / 1024, sb = b % 1024, swz = sb ^ (((sb >> 9) & 1) << 5); R = (st >> 1) * 16 + swz / 64; C = (st & 1) * 32 + (swz % 64) / 2; }
__host__ __device__ __forceinline__ int perm32(int rho) { const int n = rho >> 4, i = rho & 15; return 8 * (i >> 2) + 4 * n + (i & 3); }

struct Unit { int pm, pn; };
struct Gemm { const bf16_t* A; const bf16_t* Bt; int M, N, K; };

struct StaticOrder {
    int nM, nN, nwg, G, c;
    __host__ __device__ void init(int M, int N, int G_, int c_) { nM = M / BM; nN = N / BM; nwg = nM * nN; G = G_; c = c_; }
    __host__ __device__ bool next(int i, Unit& u) const {
        const long L = (long)i * G + c; if (L >= nwg) return false;
        int wgid = (int)L; { const int q = nwg / NXCD, r = nwg % NXCD, xcd = wgid % NXCD, off = wgid / NXCD; wgid = (xcd < r ? xcd * (q + 1) : r * (q + 1) + (xcd - r) * q) + off; }
        const int nig = WGM * nN, gid = wgid / nig, fm = gid * WGM, gsz = (nM - fm) < WGM ? (nM - fm) : WGM;
        u.pm = fm + ((wgid % nig) % gsz); u.pn = (wgid % nig) / gsz; return true;
    }
    __device__ __forceinline__ void a_ready(const Unit&) const {}
    __device__ __forceinline__ void done(const Unit&) const {}
};

__device__ __forceinline__ unsigned cvt_pk_bf16(float lo, float hi) { unsigned r; asm volatile("v_cvt_pk_bf16_f32 %0, %1, %2" : "=v"(r) : "v"(lo), "v"(hi)); return r; }
typedef float f32x2 __attribute__((ext_vector_type(2)));
template <class Epi, class Sched, bool ALIGN_EPI = false, bool SP2 = false>
__device__ __forceinline__ void gemm_phase(PG8_LAS unsigned char* lds, const Gemm g, const Sched& S, const Epi& E) {
    const int tid = threadIdx.x, wid = __builtin_amdgcn_readfirstlane(tid >> 6), lane = tid & 63, wr = wid >> 2, wc = wid & 3, fr = lane & 15, fq = lane >> 4;
    const int K = g.K, nt = K / BK;
    unsigned voffA[2], voffB[2];
#pragma unroll
    for (int i = 0; i < 2; ++i) { int R, C; stage_rc(tid * 16 + i * 8192, R, C); const int Rb = Epi::PERM ? ((R & ~31) + perm32(R & 31)) : R;
        voffA[i] = (unsigned)(R * K + C) * 2u; voffB[i] = (unsigned)(Rb * K + C) * 2u; }
    const size_t kstep = (size_t)(BK * 2);
    const size_t hstep = (size_t)HALF * K * 2;
    const size_t tstep = 2 * hstep;
    const unsigned ldsw = (unsigned)wid * 1024u;
    const int aoff = lds_byte(wr * 64 + fr, fq * 8), boff = lds_byte(wc * 32 + fr, fq * 8);
#define PG8_SA(b, h) (((b) * 2 + (h)) * HTB)
#define PG8_SB(b, h) ((4 + (b) * 2 + (h)) * HTB)
#define PG8_STAGE(bufoff, gbase, voff) do { _Pragma("unroll") for (int _i = 0; _i < 2; ++_i) \
        __builtin_amdgcn_global_load_lds((const unsigned*)((const char*)(gbase) + (voff)[_i]), (PG8_LAS unsigned*)(lds + (bufoff) + ldsw + _i * 8192), 16, 0, 0); } while (0)
#define PG8_LDA(dst, b, h) do { _Pragma("unroll") for (int m = 0; m < 4; ++m) _Pragma("unroll") for (int k = 0; k < 2; ++k) dst[m][k] = *(const PG8_LAS bf16x8*)(lds + PG8_SA(b, h) + aoff + m * 2048 + k * 1024); } while (0)
#define PG8_LDB(dst, b, h) do { _Pragma("unroll") for (int n = 0; n < 2; ++n) _Pragma("unroll") for (int k = 0; k < 2; ++k) dst[n][k] = *(const PG8_LAS bf16x8*)(lds + PG8_SB(b, h) + boff + n * 2048 + k * 1024); } while (0)
#define PG8_MMA(ai, bj, At, Bt) do { __builtin_amdgcn_s_setprio(1); _Pragma("unroll") for (int m = 0; m < 4; ++m) _Pragma("unroll") for (int n = 0; n < 2; ++n) _Pragma("unroll") for (int k = 0; k < 2; ++k) \
        acc[ai][bj][m][n] = __builtin_amdgcn_mfma_f32_16x16x32_bf16(Bt[n][k], At[m][k], acc[ai][bj][m][n], 0, 0, 0); __builtin_amdgcn_s_setprio(0); } while (0)
#define PG8_WAIT_V(n) asm volatile("s_waitcnt vmcnt(" #n ")" ::: "memory")
#define PG8_WAIT_L(n) asm volatile("s_waitcnt lgkmcnt(" #n ")" ::: "memory")
#define PG8_BAR __builtin_amdgcn_s_barrier()
#define PG8_SCHED __builtin_amdgcn_sched_barrier(0)
    Unit cur, nxt; int ui = 0;
    if (!S.next(0, cur)) return;
    f32x4 acc[2][2][4][2];
#pragma unroll
    for (int a = 0; a < 2; ++a)
#pragma unroll
        for (int b = 0; b < 2; ++b)
#pragma unroll
            for (int m = 0; m < 4; ++m)
#pragma unroll
                for (int n = 0; n < 2; ++n) acc[a][b][m][n] = (f32x4){0.f, 0.f, 0.f, 0.f};
    bf16x8 At[4][2], B0[2][2], B1[2][2];
    const char* cA = (const char*)g.A + (size_t)cur.pm * tstep; const char* cB = (const char*)g.Bt + (size_t)cur.pn * tstep;
    S.a_ready(cur);
    if constexpr (SP2) {
        PG8_STAGE(PG8_SB(0, 0), cB, voffB); PG8_STAGE(PG8_SB(0, 1), cB + hstep, voffB); PG8_STAGE(PG8_SA(0, 0), cA, voffA); PG8_STAGE(PG8_SA(0, 1), cA + hstep, voffA);
        if (wr == 1) PG8_BAR;
        PG8_WAIT_V(2); PG8_BAR;
        PG8_STAGE(PG8_SB(1, 0), cB + kstep, voffB); PG8_STAGE(PG8_SA(1, 0), cA + kstep, voffA); PG8_STAGE(PG8_SB(1, 1), cB + hstep + kstep, voffB);
        PG8_WAIT_V(6); PG8_BAR;
    } else {
        PG8_STAGE(PG8_SB(0, 0), cB, voffB); PG8_STAGE(PG8_SA(0, 0), cA, voffA); PG8_STAGE(PG8_SB(0, 1), cB + hstep, voffB); PG8_STAGE(PG8_SA(0, 1), cA + hstep, voffA);
        if (wr == 1) PG8_BAR;
        PG8_WAIT_V(4); PG8_BAR;
        PG8_STAGE(PG8_SB(1, 0), cB + kstep, voffB); PG8_STAGE(PG8_SA(1, 0), cA + kstep, voffA); PG8_STAGE(PG8_SB(1, 1), cB + hstep + kstep, voffB);
        PG8_WAIT_V(6); PG8_BAR;
    }
    for (;;) {
        const bool has_next = S.next(ui + 1, nxt);
        const char* nA = has_next ? (const char*)g.A + (size_t)nxt.pm * tstep : cA; const char* nB = has_next ? (const char*)g.Bt + (size_t)nxt.pn * tstep : cB;
        for (int t = 0; t < nt; t += 2) {
            const bool last = (t == nt - 2);
            const char* a1 = cA + (size_t)(t + 1) * kstep;
            const char* a2 = last ? nA : cA + (size_t)(t + 2) * kstep; const char* b2 = last ? nB : cB + (size_t)(t + 2) * kstep;
            const char* a3 = a2 + kstep; const char* b3 = b2 + kstep;
            if (last && has_next) S.a_ready(nxt);
            if constexpr (SP2) {
            PG8_LDB(B0, 0, 0); PG8_LDB(B1, 0, 1); PG8_SCHED; PG8_LDA(At, 0, 0); PG8_STAGE(PG8_SA(1, 1), a1 + hstep, voffA);
            PG8_WAIT_V(8); PG8_WAIT_L(0); PG8_BAR; PG8_MMA(0, 0, At, B0); PG8_MMA(0, 1, At, B1); PG8_BAR; PG8_SCHED;
            PG8_LDA(At, 0, 1); PG8_STAGE(PG8_SB(0, 0), b2, voffB); PG8_STAGE(PG8_SB(0, 1), b2 + hstep, voffB); PG8_STAGE(PG8_SA(0, 0), a2, voffA);
            PG8_WAIT_V(8); PG8_WAIT_L(0); PG8_BAR; PG8_MMA(1, 0, At, B0); PG8_MMA(1, 1, At, B1); PG8_BAR; PG8_SCHED;
            PG8_LDB(B0, 1, 0); PG8_LDB(B1, 1, 1); PG8_SCHED; PG8_LDA(At, 1, 0); PG8_STAGE(PG8_SA(0, 1), a2 + hstep, voffA);
            PG8_WAIT_V(8); PG8_WAIT_L(0); PG8_BAR; PG8_MMA(0, 0, At, B0); PG8_MMA(0, 1, At, B1); PG8_BAR; PG8_SCHED;
            PG8_LDA(At, 1, 1); PG8_STAGE(PG8_SB(1, 0), b3, voffB); PG8_STAGE(PG8_SB(1, 1), b3 + hstep, voffB); PG8_STAGE(PG8_SA(1, 0), a3, voffA);
            PG8_WAIT_V(8); PG8_WAIT_L(0); PG8_BAR; PG8_MMA(1, 0, At, B0); PG8_MMA(1, 1, At, B1); PG8_BAR; PG8_SCHED;
            } else {
            PG8_LDB(B0, 0, 0); PG8_SCHED; PG8_LDA(At, 0, 0); PG8_STAGE(PG8_SA(1, 1), a1 + hstep, voffA);
            PG8_WAIT_L(8); PG8_BAR; PG8_WAIT_L(0); PG8_MMA(0, 0, At, B0); PG8_BAR; PG8_SCHED;
            PG8_LDB(B1, 0, 1); PG8_STAGE(PG8_SB(0, 0), b2, voffB);
            PG8_BAR; PG8_WAIT_L(0); PG8_MMA(0, 1, At, B1); PG8_BAR;
            PG8_LDA(At, 0, 1); PG8_STAGE(PG8_SA(0, 0), a2, voffA);
            PG8_BAR; PG8_WAIT_L(0); PG8_MMA(1, 0, At, B0); PG8_BAR; PG8_SCHED;
            PG8_STAGE(PG8_SB(0, 1), b2 + hstep, voffB);
            PG8_WAIT_V(6); PG8_BAR; PG8_MMA(1, 1, At, B1); PG8_BAR;
            PG8_LDB(B0, 1, 0); PG8_SCHED; PG8_LDA(At, 1, 0); PG8_STAGE(PG8_SA(0, 1), a2 + hstep, voffA);
            PG8_WAIT_L(8); PG8_BAR; PG8_WAIT_L(0); PG8_MMA(0, 0, At, B0); PG8_BAR; PG8_SCHED;
            PG8_LDB(B1, 1, 1); PG8_STAGE(PG8_SB(1, 0), b3, voffB);
            PG8_BAR; PG8_WAIT_L(0); PG8_MMA(0, 1, At, B1); PG8_BAR;
            PG8_LDA(At, 1, 1); PG8_STAGE(PG8_SA(1, 0), a3, voffA);
            PG8_BAR; PG8_WAIT_L(0); PG8_MMA(1, 0, At, B0); PG8_BAR; PG8_SCHED;
            PG8_STAGE(PG8_SB(1, 1), b3 + hstep, voffB);
            PG8_WAIT_V(6); PG8_BAR; PG8_MMA(1, 1, At, B1); PG8_BAR;
            }
        }
        if constexpr (ALIGN_EPI) { if (wr == 0) PG8_BAR; }
        if constexpr (!Epi::AFTER_DRAIN) { E(acc, cur, wr, wc, fr, fq); S.done(cur); }
        if (!has_next) break;
#pragma unroll
        for (int a = 0; a < 2; ++a)
#pragma unroll
            for (int b = 0; b < 2; ++b)
#pragma unroll
                for (int m = 0; m < 4; ++m)
#pragma unroll
                    for (int n = 0; n < 2; ++n) acc[a][b][m][n] = (f32x4){0.f, 0.f, 0.f, 0.f};
        cur = nxt; cA = nA; cB = nB; ++ui;
        if constexpr (ALIGN_EPI) { if (wr == 1) PG8_BAR; }
    }
    PG8_WAIT_V(0);
    if constexpr (!ALIGN_EPI) { if (wr == 0) PG8_BAR; }
    PG8_BAR;
    if constexpr (Epi::AFTER_DRAIN) { E.fused(acc, cur, wr, wc, fr, fq, lds, wid, lane); S.done(cur); }
#undef PG8_SA
#undef PG8_SB
#undef PG8_STAGE
#undef PG8_LDA
#undef PG8_LDB
#undef PG8_MMA
#undef PG8_WAIT_V
#undef PG8_WAIT_L
#undef PG8_BAR
#undef PG8_SCHED
}
}
namespace pg8 {
typedef unsigned u32x2 __attribute__((ext_vector_type(2)));
constexpr int LD_QKV = 2304, LD_D = 1024, LD_FF = 2816;
constexpr float RMS_EPS = 1e-5f;

struct EpiQKV {
    static constexpr bool PERM = true, AFTER_DRAIN = false;
    bf16_t* O; const float* bias;
    __device__ __forceinline__ void operator()(const f32x4 (&acc)[2][2][4][2], const Unit& u, int wr, int wc, int fr, int fq) const {
        const int row0 = u.pm * BM + wr * 64 + fr, col0 = u.pn * BM + wc * 32 + 8 * fq;
        const float sc = (u.pn < 2 || u.pn == 3 || u.pn == 4) ? 0.125f : 1.0f;
        f32x4 bv[2][2];
#pragma unroll
        for (int bj = 0; bj < 2; ++bj)
#pragma unroll
            for (int n = 0; n < 2; ++n) bv[bj][n] = *(const f32x4*)(bias + col0 + bj * HALF + 4 * n);
#pragma unroll
        for (int ai = 0; ai < 2; ++ai)
#pragma unroll
            for (int m = 0; m < 4; ++m) { bf16_t* rowp = O + (size_t)(row0 + ai * HALF + m * 16) * LD_QKV + col0;
#pragma unroll
                for (int bj = 0; bj < 2; ++bj) { f32x4 v0 = (acc[ai][bj][m][0] + bv[bj][0]) * sc, v1 = (acc[ai][bj][m][1] + bv[bj][1]) * sc;
                    u32x4 w; w.x = cvt_pk_bf16(v0[0], v0[1]); w.y = cvt_pk_bf16(v0[2], v0[3]); w.z = cvt_pk_bf16(v1[0], v1[1]); w.w = cvt_pk_bf16(v1[2], v1[3]);
                    *(u32x4*)(rowp + bj * HALF) = w; } }
    }
};
struct EpiRes1 {
    static constexpr bool PERM = false, AFTER_DRAIN = false;
    const float* X; float* X1; bf16_t* X1B; float* ssq;
    __device__ __forceinline__ void operator()(const f32x4 (&acc)[2][2][4][2], const Unit& u, int wr, int wc, int fr, int fq) const {
        const int row0 = u.pm * BM + wr * 64 + fr, col0 = u.pn * BM + wc * 32 + 4 * fq;
#pragma unroll
        for (int ai = 0; ai < 2; ++ai)
#pragma unroll
            for (int m = 0; m < 4; ++m) { const int r = row0 + ai * HALF + m * 16; const size_t off = (size_t)r * LD_D + col0; float ss = 0.f;
#pragma unroll
                for (int bj = 0; bj < 2; ++bj)
#pragma unroll
                    for (int n = 0; n < 2; ++n) { const f32x4 xv = *(const f32x4*)(X + off + bj * HALF + n * 16); const f32x4 o = xv + acc[ai][bj][m][n];
                        *(f32x4*)(X1 + off + bj * HALF + n * 16) = o; u32x2 w; w.x = cvt_pk_bf16(o[0], o[1]); w.y = cvt_pk_bf16(o[2], o[3]);
                        *(u32x2*)(X1B + off + bj * HALF + n * 16) = w; ss += (o[0] * o[0] + o[1] * o[1]) + (o[2] * o[2] + o[3] * o[3]); }
                ss += __shfl_xor(ss, 16); ss += __shfl_xor(ss, 32);
                if (fq == 0) atomicAdd(ssq + r, ss);
                if (m & 1) asm volatile("" ::: "memory"); }
    }
};
struct EpiSwiGLU {
    static constexpr bool PERM = true, AFTER_DRAIN = false;
    bf16_t* ACT; const float* ssq;
    __device__ __forceinline__ void operator()(const f32x4 (&acc)[2][2][4][2], const Unit& u, int wr, int wc, int fr, int fq) const {
        const int row0 = u.pm * BM + wr * 64 + fr, col0 = u.pn * HALF + wc * 32 + 8 * fq;
#pragma unroll
        for (int ai = 0; ai < 2; ++ai)
#pragma unroll
            for (int m = 0; m < 4; ++m) { const int r = row0 + ai * HALF + m * 16;
                const float rs = 1.0f / sqrtf(ssq[r] * (1.0f / 1024.0f) + RMS_EPS);
                float a[8];
#pragma unroll
                for (int n = 0; n < 2; ++n)
#pragma unroll
                    for (int e = 0; e < 4; ++e) { const float g = acc[ai][0][m][n][e] * rs, up = acc[ai][1][m][n][e] * rs;
                        const float sg = g * __builtin_amdgcn_rcpf(1.0f + __builtin_amdgcn_exp2f(-1.4426950408889634f * g)); a[n * 4 + e] = sg * up; }
                u32x4 w; w.x = cvt_pk_bf16(a[0], a[1]); w.y = cvt_pk_bf16(a[2], a[3]); w.z = cvt_pk_bf16(a[4], a[5]); w.w = cvt_pk_bf16(a[6], a[7]);
                *(u32x4*)(ACT + (size_t)r * LD_FF + col0) = w; }
    }
};
struct EpiRes2 {
    static constexpr bool PERM = false, AFTER_DRAIN = false;
    float* X1;
    __device__ __forceinline__ void operator()(const f32x4 (&acc)[2][2][4][2], const Unit& u, int wr, int wc, int fr, int fq) const {
        const int row0 = u.pm * BM + wr * 64 + fr, col0 = u.pn * BM + wc * 32 + 4 * fq;
#pragma unroll
        for (int ai = 0; ai < 2; ++ai)
#pragma unroll
            for (int m = 0; m < 4; ++m) { const size_t off = (size_t)(row0 + ai * HALF + m * 16) * LD_D + col0;
#pragma unroll
                for (int bj = 0; bj < 2; ++bj)
#pragma unroll
                    for (int n = 0; n < 2; ++n) { float* p = X1 + off + bj * HALF + n * 16; const f32x4 xv = *(const f32x4*)p; *(f32x4*)p = xv + acc[ai][bj][m][n]; }
                if (m & 1) asm volatile("" ::: "memory"); }
    }
};
}
#define GAS __attribute__((address_space(1)))
#define LAS __attribute__((address_space(3)))
typedef unsigned short bf16;
typedef unsigned v4u __attribute__((ext_vector_type(4)));
typedef float f32x4 __attribute__((ext_vector_type(4)));
constexpr int BATCH = 8, SEQ = 8192, DM = 1024, M = BATCH * SEQ, NP = 2304, FF = 2816, NGU = 2 * FF;
constexpr float EPS = 1e-5f;
constexpr size_t MiB = 1u << 20;
constexpr size_t WS_SSQ1 = 0, WS_BIAS = 512 * 1024, WS_ROPE = 1 * MiB;
constexpr size_t WS_W1 = 4 * MiB, WS_W2 = 9 * MiB, WS_W3 = 11 * MiB, WS_W4 = 22 * MiB;
constexpr size_t WS_XN = 32 * MiB;
constexpr size_t WS_QKV = 160 * MiB;
constexpr size_t WS_OA = 448 * MiB, WS_OB = 512 * MiB;
constexpr size_t WS_LSE = 704 * MiB;
constexpr size_t WS_X1B = 160 * MiB;
constexpr size_t WS_ACT = 288 * MiB;
constexpr size_t WS_END = 712 * MiB;
constexpr int BIAS_LD = 132;
constexpr int LDS_BYTES = 147456;

__device__ __forceinline__ unsigned pk2(float lo, float hi) { return pg8::cvt_pk_bf16(lo, hi); }
__device__ __forceinline__ float bflo(unsigned w) { return __uint_as_float(w << 16); }
__device__ __forceinline__ float bfhi(unsigned w) { return __uint_as_float(w & 0xffff0000u); }
__device__ __forceinline__ float wave_sum(float v) {
#pragma unroll
    for (int o = 1; o < 64; o <<= 1) v += __shfl_xor(v, o);
    return v;
}
__device__ __forceinline__ void tr_item(const float* W, int K, int N, int k0, int n0, bf16* WT, int r0, LAS float* scr, int lane, const float* gk) {
#pragma unroll 8
    for (int i = 0; i < 32; ++i) { const int kk = 2 * i + (lane >> 5); float v = W[(size_t)(k0 + kk) * N + n0 + (lane & 31)]; if (gk) v *= gk[k0 + kk]; scr[kk * 33 + (lane & 31)] = v; }
    asm volatile("s_waitcnt lgkmcnt(0)" ::: "memory");
    const int c = lane & 7;
#pragma unroll
    for (int j = 0; j < 4; ++j) { const int n = (lane >> 3) + 8 * j; const LAS float* s = scr + (8 * c) * 33 + n;
        v4u o; o.x = pk2(s[0 * 33], s[1 * 33]); o.y = pk2(s[2 * 33], s[3 * 33]); o.z = pk2(s[4 * 33], s[5 * 33]); o.w = pk2(s[6 * 33], s[7 * 33]);
        *(v4u*)(WT + (size_t)(r0 + n) * K + k0 + 8 * c) = o; }
    asm volatile("s_waitcnt lgkmcnt(0)" ::: "memory");
}
__device__ __forceinline__ int t5_bucket(int dist) {
    if (dist < 16) return dist;
    const float df = (float)dist;
    int large = 16 + (int)((logf(df / 16.0f) / 4.852030263919617f) * 16.0f);
    return large < 31 ? large : 31;
}

struct Args { const float* in[14]; float* out; unsigned char* ws; };

__device__ __forceinline__ void naive_attn(const bf16* QKV, bf16* OA, bf16* OB, float* LSE, const float* sinks, const float* biasT, int gt, int NGT) {
    for (int it = gt; it < 4 * 8 * M; it += NGT) {
        const int m = it & (M - 1), ch = it >> 16, c = ch >> 3, h = ch & 7, pos = m & (SEQ - 1);
        int qcol, kcol, vcol, dil, nb;
        if (c == 0) { qcol = h * 64; kcol = 512 + (h >> 2) * 64; vcol = 640 + (h >> 2) * 64; dil = 1; nb = 127; }
        else { qcol = 768 + h * 64; kcol = 1280 + h * 64; vcol = 1792 + h * 64; dil = (c == 1) ? 1 : (c == 2 ? 4 : 16); nb = 128; }
        float q[64], o[64];
        { const v4u* qp = (const v4u*)(QKV + (size_t)m * NP + qcol);
#pragma unroll
          for (int j = 0; j < 8; ++j) { const v4u w = qp[j]; q[8*j+0] = bflo(w.x); q[8*j+1] = bfhi(w.x); q[8*j+2] = bflo(w.y); q[8*j+3] = bfhi(w.y); q[8*j+4] = bflo(w.z); q[8*j+5] = bfhi(w.z); q[8*j+6] = bflo(w.w); q[8*j+7] = bfhi(w.w); } }
#pragma unroll
        for (int j = 0; j < 64; ++j) o[j] = 0.f;
        float mx = (c == 0) ? sinks[h] : -1e30f, l = (c == 0) ? 1.f : 0.f;
        const float* bt = biasT + ((c > 0 ? c - 1 : 0) * 8 + h) * BIAS_LD;
        for (int d = 0; d <= nb; ++d) {
            const int kp = pos - d * dil; if (kp < 0) break;
            const bf16* row = QKV + (size_t)(m - d * dil) * NP;
            const v4u* kr = (const v4u*)(row + kcol); float s = 0.f;
#pragma unroll
            for (int j = 0; j < 8; ++j) { const v4u w = kr[j];
                s += q[8*j+0] * bflo(w.x) + q[8*j+1] * bfhi(w.x) + q[8*j+2] * bflo(w.y) + q[8*j+3] * bfhi(w.y) + q[8*j+4] * bflo(w.z) + q[8*j+5] * bfhi(w.z) + q[8*j+6] * bflo(w.w) + q[8*j+7] * bfhi(w.w); }
            if (c) s += bt[d];
            const float mn = fmaxf(mx, s), al = __expf(mx - mn), p = __expf(s - mn);
            l = l * al + p; mx = mn;
            const v4u* vr = (const v4u*)(row + vcol);
#pragma unroll
            for (int j = 0; j < 8; ++j) { const v4u w = vr[j];
                o[8*j+0] = o[8*j+0] * al + p * bflo(w.x); o[8*j+1] = o[8*j+1] * al + p * bfhi(w.x); o[8*j+2] = o[8*j+2] * al + p * bflo(w.y); o[8*j+3] = o[8*j+3] * al + p * bfhi(w.y);
                o[8*j+4] = o[8*j+4] * al + p * bflo(w.z); o[8*j+5] = o[8*j+5] * al + p * bfhi(w.z); o[8*j+6] = o[8*j+6] * al + p * bflo(w.w); o[8*j+7] = o[8*j+7] * al + p * bfhi(w.w); }
        }
        const float inv = 1.0f / l;
        bf16* op = (c == 0) ? (OA + (size_t)m * 512 + h * 64) : (OB + (size_t)(c - 1) * M * 512 + (size_t)m * 512 + h * 64);
#pragma unroll
        for (int j = 0; j < 8; ++j) { v4u w; w.x = pk2(o[8*j+0] * inv, o[8*j+1] * inv); w.y = pk2(o[8*j+2] * inv, o[8*j+3] * inv); w.z = pk2(o[8*j+4] * inv, o[8*j+5] * inv); w.w = pk2(o[8*j+6] * inv, o[8*j+7] * inv); ((v4u*)op)[j] = w; }
        if (c) LSE[(size_t)(c - 1) * M * 8 + (size_t)m * 8 + h] = mx + logf(l);
    }
}

namespace att {
typedef short bf16x8 __attribute__((ext_vector_type(8)));
typedef short s16x4 __attribute__((ext_vector_type(4)));
typedef float f32x16 __attribute__((ext_vector_type(16)));
typedef unsigned u32x2 __attribute__((ext_vector_type(2)));
typedef short v4i16_t __attribute__((ext_vector_type(4)));
__device__ __forceinline__ int crow(int i, int hi) { return (i & 3) + 8 * (i >> 2) + 4 * hi; }
__device__ __forceinline__ s16x4 vtr(LAS const char* p) { return __builtin_bit_cast(s16x4, __builtin_amdgcn_ds_read_tr16_b64_v4i16((LAS v4i16_t*)p)); }
constexpr int ATT_BIAS_BYTES = 16384, ATT_VBUF = 8192;

template <int C>
__device__ __forceinline__ void attn_item(const bf16* QKV, bf16* Oout, float* LSEout, int b, int h, int dil, int res, int l0, float sink,
                                          const LAS float* btab, LAS char* vbuf, int lane) {
    constexpr int NB = C == 0 ? 127 : 128;
    const int r = lane & 31, hi = lane >> 5;
    const int qcol = C == 0 ? h * 64 : 768 + h * 64, kcol = C == 0 ? 512 + (h >> 2) * 64 : 1280 + h * 64, vcol = C == 0 ? 640 + (h >> 2) * 64 : 1792 + h * 64;
    const size_t rowq = (size_t)(b * SEQ + res + dil * (l0 + r));
    bf16x8 qf[4];
    { const bf16* qp = QKV + rowq * NP + qcol + 8 * hi;
#pragma unroll
      for (int ks = 0; ks < 4; ++ks) qf[ks] = *(const bf16x8*)(qp + 16 * ks); }
    const int t0 = l0 >= 128 ? 0 : ((128 - l0) >> 5);
    f32x16 S[5];
#pragma unroll
    for (int t = 0; t < 5; ++t) {
        if (t >= t0) {
            const size_t krow = (size_t)(b * SEQ + res + dil * (l0 - 128 + 32 * t + r));
            const bf16* kp = QKV + krow * NP + kcol + 8 * hi;
            bf16x8 kf[4];
#pragma unroll
            for (int ks = 0; ks < 4; ++ks) kf[ks] = *(const bf16x8*)(kp + 16 * ks);
            f32x16 acc = {};
#pragma unroll
            for (int ks = 0; ks < 4; ++ks) acc = __builtin_amdgcn_mfma_f32_32x32x16_bf16(kf[ks], qf[ks], acc, 0, 0, 0);
            S[t] = acc;
        } else {
#pragma unroll
            for (int i = 0; i < 16; ++i) S[t][i] = 0.f;
        }
    }
    float mx = C == 0 ? sink : -1e30f;
#pragma unroll
    for (int t = 0; t < 5; ++t)
#pragma unroll
        for (int i = 0; i < 16; ++i) {
            const int delta = 128 - 32 * t + r - crow(i, hi);
            const bool valid = (t >= t0) && delta >= 0 && delta <= NB;
            float s = S[t][i];
            if (C == 1) { const int dc = delta < 0 ? 0 : (delta > 128 ? 128 : delta); s += btab[dc]; }
            s = valid ? s : -INFINITY; S[t][i] = s; mx = fmaxf(mx, s);
        }
    mx = fmaxf(mx, __shfl_xor(mx, 32));
    float l = 0.f;
#pragma unroll
    for (int t = 0; t < 5; ++t)
#pragma unroll
        for (int i = 0; i < 16; ++i) { const float p = __expf(S[t][i] - mx); S[t][i] = p; l += p; }
    l += __shfl_xor(l, 32);
    if (C == 0) l += __expf(sink - mx);
    f32x16 o0 = {}, o1 = {};
    const int vrd = ((lane >> 4) & 1) * 32 + (lane & 3) * 8 + (4 * hi + ((lane & 15) >> 2)) * 64;
#pragma unroll
    for (int t = 0; t < 5; ++t) {
        if (t >= t0) {
            LAS char* vb = vbuf + (t & 1) * 4096;
#pragma unroll
            for (int i = 0; i < 4; ++i) { const int key = 8 * i + (lane >> 3), c = lane & 7;
                const size_t vrow = (size_t)(b * SEQ + res + dil * (l0 - 128 + 32 * t + key));
                const v4u w = *(const v4u*)(QKV + vrow * NP + vcol + 8 * c);
                *(LAS v4u*)(vb + (c >> 2) * 2048 + key * 64 + (c & 3) * 16) = w; }
            bf16x8 pf[2];
#pragma unroll
            for (int s = 0; s < 2; ++s) { v4u w; w.x = pk2(S[t][8*s+0], S[t][8*s+1]); w.y = pk2(S[t][8*s+2], S[t][8*s+3]); w.z = pk2(S[t][8*s+4], S[t][8*s+5]); w.w = pk2(S[t][8*s+6], S[t][8*s+7]);
                pf[s] = __builtin_bit_cast(bf16x8, w); }
#pragma unroll
            for (int s = 0; s < 2; ++s) {
                const s16x4 a0 = vtr(vb + vrd + s * 1024), a1 = vtr(vb + vrd + s * 1024 + 512);
                const s16x4 c0 = vtr(vb + vrd + 2048 + s * 1024), c1 = vtr(vb + vrd + 2048 + s * 1024 + 512);
                const bf16x8 v0 = (bf16x8){a0[0], a0[1], a0[2], a0[3], a1[0], a1[1], a1[2], a1[3]};
                const bf16x8 v1 = (bf16x8){c0[0], c0[1], c0[2], c0[3], c1[0], c1[1], c1[2], c1[3]};
                o0 = __builtin_amdgcn_mfma_f32_32x32x16_bf16(v0, pf[s], o0, 0, 0, 0);
                o1 = __builtin_amdgcn_mfma_f32_32x32x16_bf16(v1, pf[s], o1, 0, 0, 0);
            }
        }
    }
    const float inv = 1.0f / l;
    bf16* op = Oout + rowq * 512 + h * 64 + 4 * hi;
#pragma unroll
    for (int g = 0; g < 4; ++g) {
        u32x2 w; w.x = pk2(o0[4*g+0] * inv, o0[4*g+1] * inv); w.y = pk2(o0[4*g+2] * inv, o0[4*g+3] * inv); *(u32x2*)(op + 8 * g) = w;
        u32x2 z; z.x = pk2(o1[4*g+0] * inv, o1[4*g+1] * inv); z.y = pk2(o1[4*g+2] * inv, o1[4*g+3] * inv); *(u32x2*)(op + 32 + 8 * g) = z;
    }
    if (C == 1 && hi == 0) LSEout[rowq * 8 + h] = mx + logf(l);
}
}
__global__ void __launch_bounds__(512, 2) hymba_fwd(Args a) {
    extern __shared__ __attribute__((aligned(16))) unsigned char lds[];
    cg::grid_group grid = cg::this_grid();
    const int tid = threadIdx.x, lane = tid & 63, wave = __builtin_amdgcn_readfirstlane(tid >> 6);
    const int G = gridDim.x, bid = blockIdx.x;
    const int gw = bid * 8 + wave, NGW = G * 8, gt = bid * 512 + tid, NGT = G * 512;
    unsigned char* ws = a.ws;
    const float* x = a.in[0]; const float* g_attn = a.in[1]; const float* w_in = a.in[2]; const float* b_in = a.in[3]; const float* sinks = a.in[4];
    const float* rel_table = a.in[5]; const float* g_out_a = a.in[6]; const float* g_out_b = a.in[7]; const float* w_o = a.in[8]; const float* g_ffn = a.in[9];
    const float* w_gate = a.in[10]; const float* w_up = a.in[11]; const float* w_down = a.in[12]; const float* g_final = a.in[13];
    float* out = a.out;
    float* ssq1 = (float*)(ws + WS_SSQ1); float* biasT = (float*)(ws + WS_BIAS); float* ropeC = (float*)(ws + WS_ROPE); float* ropeS = ropeC + SEQ * 32;
    bf16* W1t = (bf16*)(ws + WS_W1); bf16* W2t = (bf16*)(ws + WS_W2); bf16* W3t = (bf16*)(ws + WS_W3); bf16* W4t = (bf16*)(ws + WS_W4);
    bf16* XN = (bf16*)(ws + WS_XN); bf16* QKV = (bf16*)(ws + WS_QKV); bf16* OA = (bf16*)(ws + WS_OA); bf16* OB = (bf16*)(ws + WS_OB);
    float* LSE = (float*)(ws + WS_LSE); bf16* X1B = (bf16*)(ws + WS_X1B); bf16* ACT = (bf16*)(ws + WS_ACT);
    LAS unsigned char* ldsl = (LAS unsigned char*)lds;

    {
        LAS float* scr = (LAS float*)(ldsl + wave * 16384);
        constexpr int I1 = 16 * 72, I2 = 16 * 32, I3 = 16 * 88, I4 = 44 * 32, NIT = I1 + I2 + 2 * I3 + I4;
        for (int it = gw; it < NIT; it += NGW) {
            int r = it;
            if (r < I1) { const int kb = r / 72, nb = r % 72; tr_item(w_in, DM, NP, 64 * kb, 32 * nb, W1t, 32 * nb, scr, lane, nullptr); continue; } r -= I1;
            if (r < I2) { const int kb = r / 32, nb = r % 32; tr_item(w_o, DM, DM, 64 * kb, 32 * nb, W2t, 32 * nb, scr, lane, nullptr); continue; } r -= I2;
            if (r < I3) { const int kb = r / 88, nb = r % 88, n0 = 32 * nb; tr_item(w_gate, DM, FF, 64 * kb, n0, W3t, 256 * (n0 >> 7) + (n0 & 127), scr, lane, g_ffn); continue; } r -= I3;
            if (r < I3) { const int kb = r / 88, nb = r % 88, n0 = 32 * nb; tr_item(w_up, DM, FF, 64 * kb, n0, W3t, 256 * (n0 >> 7) + 128 + (n0 & 127), scr, lane, g_ffn); continue; } r -= I3;
            { const int kb = r / 32, nb = r % 32; tr_item(w_down, FF, DM, 64 * kb, 32 * nb, W4t, 32 * nb, scr, lane, nullptr); }
        }
        for (int m = gw; m < M; m += NGW) {
            const f32x4* xr = (const f32x4*)(x + (size_t)m * DM) + lane; f32x4 v[4]; float s = 0.f;
#pragma unroll
            for (int j = 0; j < 4; ++j) { v[j] = xr[64 * j]; s += (v[j].x * v[j].x + v[j].y * v[j].y) + (v[j].z * v[j].z + v[j].w * v[j].w); }
            const float rs = 1.0f / sqrtf(wave_sum(s) * (1.0f / DM) + EPS);
            unsigned long long* o8 = (unsigned long long*)(XN + (size_t)m * DM) + lane;
#pragma unroll
            for (int j = 0; j < 4; ++j) { const f32x4 g = ((const f32x4*)g_attn)[lane + 64 * j];
                o8[64 * j] = (unsigned long long)pk2(v[j].x * rs * g.x, v[j].y * rs * g.y) | ((unsigned long long)pk2(v[j].z * rs * g.z, v[j].w * rs * g.w) << 32); }
        }
        for (int i = gt; i < SEQ * 32; i += NGT) { const int pos = i >> 5, f = i & 31;
            const float inv_freq = (float)exp2(-(double)f * (17.194602975157967 / 32.0));
            const float ang = (float)pos * inv_freq;
            double rev = (double)ang * 0.15915494309189535; rev -= rint(rev);
            ropeC[i] = __builtin_amdgcn_cosf((float)rev); ropeS[i] = __builtin_amdgcn_sinf((float)rev); }
        for (int i = gt; i < 3 * 8 * 129; i += NGT) { const int d = i % 129, bh = i / 129, h = bh & 7, br = bh >> 3; const int dil = br == 0 ? 1 : (br == 1 ? 4 : 16);
            biasT[bh * BIAS_LD + d] = rel_table[t5_bucket(d * dil) * 8 + h]; }
        for (int i = gt; i < M; i += NGT) ssq1[i] = 0.f;
    }
    grid.sync();
    { pg8::Gemm g{XN, W1t, M, NP, DM}; pg8::StaticOrder S; S.init(M, NP, G, bid); pg8::EpiQKV E{QKV, b_in};
      pg8::gemm_phase<pg8::EpiQKV, pg8::StaticOrder, true, true>(ldsl, g, S, E); }
    grid.sync();
    for (int i = gt; i < M * 320; i += NGT) { const int f = i & 31, hh = (i >> 5) % 10, m = i / 320, pos = m & (SEQ - 1);
        const int col = hh < 8 ? hh * 64 : 512 + (hh - 8) * 64; bf16* p = QKV + (size_t)m * NP + col + f;
        const float t1 = __uint_as_float((unsigned)p[0] << 16), t2 = __uint_as_float((unsigned)p[32] << 16), c = ropeC[pos * 32 + f], s = ropeS[pos * 32 + f];
        const unsigned w = pk2(t1 * c - t2 * s, t1 * s + t2 * c); p[0] = (bf16)(w & 0xffffu); p[32] = (bf16)(w >> 16); }
    grid.sync();
#ifdef NAIVE_ATTN
    naive_attn(QKV, OA, OB, LSE, sinks, biasT, gt, NGT);
#else
    {
        LAS float* lbias = (LAS float*)ldsl;
        for (int i = tid; i < 3 * 8 * BIAS_LD; i += 512) lbias[i] = biasT[i];
        __syncthreads();
        LAS char* vbuf = (LAS char*)ldsl + att::ATT_BIAS_BYTES + wave * att::ATT_VBUF;
        const int h = wave;
        for (int u = bid; u < 4 * 8 * 256; u += G) {
            const int c = u >> 11, b = (u >> 8) & 7, rb = u & 255;
            if (c == 0) att::attn_item<0>(QKV, OA, nullptr, b, h, 1, 0, rb * 32, sinks[h], lbias, vbuf, lane);
            else { const int dil = c == 1 ? 1 : (c == 2 ? 4 : 16), nblk = 256 / dil, res = rb / nblk, l0 = (rb % nblk) * 32;
                att::attn_item<1>(QKV, OB + (size_t)(c - 1) * M * 512, LSE + (size_t)(c - 1) * M * 8, b, h, dil, res, l0, 0.f, lbias + ((c - 1) * 8 + h) * BIAS_LD, vbuf, lane); }
        }
        __syncthreads();
    }
#endif
    grid.sync();
    for (int m = gw; m < M; m += NGW) {
        float v[16];
        if (lane < 32) { const v4u* p = (const v4u*)(OA + (size_t)m * 512 + lane * 16);
#pragma unroll
            for (int j = 0; j < 2; ++j) { const v4u w = p[j]; v[8*j+0] = bflo(w.x); v[8*j+1] = bfhi(w.x); v[8*j+2] = bflo(w.y); v[8*j+3] = bfhi(w.y); v[8*j+4] = bflo(w.z); v[8*j+5] = bfhi(w.z); v[8*j+6] = bflo(w.w); v[8*j+7] = bfhi(w.w); }
        } else { const int cb = (lane - 32) * 16, h = cb >> 6;
            const float l1 = LSE[(size_t)m * 8 + h], l2 = LSE[(size_t)M * 8 + (size_t)m * 8 + h], l3 = LSE[(size_t)2 * M * 8 + (size_t)m * 8 + h];
            const float mxl = fmaxf(l1, fmaxf(l2, l3)); float w1 = __expf(l1 - mxl), w2 = __expf(l2 - mxl), w3 = __expf(l3 - mxl); const float wi = 1.0f / (w1 + w2 + w3); w1 *= wi; w2 *= wi; w3 *= wi;
#pragma unroll
            for (int j = 0; j < 16; ++j) v[j] = 0.f;
#pragma unroll
            for (int br = 0; br < 3; ++br) { const float wb = br == 0 ? w1 : (br == 1 ? w2 : w3); const v4u* p = (const v4u*)(OB + (size_t)br * M * 512 + (size_t)m * 512 + cb);
#pragma unroll
                for (int j = 0; j < 2; ++j) { const v4u w = p[j]; v[8*j+0] += wb * bflo(w.x); v[8*j+1] += wb * bfhi(w.x); v[8*j+2] += wb * bflo(w.y); v[8*j+3] += wb * bfhi(w.y); v[8*j+4] += wb * bflo(w.z); v[8*j+5] += wb * bfhi(w.z); v[8*j+6] += wb * bflo(w.w); v[8*j+7] += wb * bfhi(w.w); } }
        }
        float ss = 0.f;
#pragma unroll
        for (int j = 0; j < 16; ++j) ss += v[j] * v[j];
#pragma unroll
        for (int o = 1; o < 32; o <<= 1) ss += __shfl_xor(ss, o);
        const float rs = 1.0f / sqrtf(ss * (1.0f / 512.0f) + EPS);
        const float* gp = (lane < 32) ? (g_out_a + lane * 16) : (g_out_b + (lane - 32) * 16);
        v4u w0, w1v;
        w0.x = pk2(v[0] * rs * gp[0], v[1] * rs * gp[1]); w0.y = pk2(v[2] * rs * gp[2], v[3] * rs * gp[3]); w0.z = pk2(v[4] * rs * gp[4], v[5] * rs * gp[5]); w0.w = pk2(v[6] * rs * gp[6], v[7] * rs * gp[7]);
        w1v.x = pk2(v[8] * rs * gp[8], v[9] * rs * gp[9]); w1v.y = pk2(v[10] * rs * gp[10], v[11] * rs * gp[11]); w1v.z = pk2(v[12] * rs * gp[12], v[13] * rs * gp[13]); w1v.w = pk2(v[14] * rs * gp[14], v[15] * rs * gp[15]);
        v4u* op = (v4u*)(XN + (size_t)m * DM + lane * 16); op[0] = w0; op[1] = w1v;
    }
    grid.sync();
    { pg8::Gemm g{XN, W2t, M, DM, DM}; pg8::StaticOrder S; S.init(M, DM, G, bid); pg8::EpiRes1 E{x, out, X1B, ssq1};
      pg8::gemm_phase<pg8::EpiRes1, pg8::StaticOrder, true, true>(ldsl, g, S, E); }
    grid.sync();
    { pg8::Gemm g{X1B, W3t, M, NGU, DM}; pg8::StaticOrder S; S.init(M, NGU, G, bid); pg8::EpiSwiGLU E{ACT, ssq1};
      pg8::gemm_phase<pg8::EpiSwiGLU, pg8::StaticOrder, true, true>(ldsl, g, S, E); }
    grid.sync();
    { pg8::Gemm g{ACT, W4t, M, DM, FF}; pg8::StaticOrder S; S.init(M, DM, G, bid); pg8::EpiRes2 E{out};
      pg8::gemm_phase<pg8::EpiRes2, pg8::StaticOrder, true, true>(ldsl, g, S, E); }
    grid.sync();
    for (int m = gw; m < M; m += NGW) {
        f32x4* xr = (f32x4*)(out + (size_t)m * DM) + lane; f32x4 v[4]; float s = 0.f;
#pragma unroll
        for (int j = 0; j < 4; ++j) { v[j] = xr[64 * j]; s += (v[j].x * v[j].x + v[j].y * v[j].y) + (v[j].z * v[j].z + v[j].w * v[j].w); }
        const float rs = 1.0f / sqrtf(wave_sum(s) * (1.0f / DM) + EPS);
#pragma unroll
        for (int j = 0; j < 4; ++j) { const f32x4 g = ((const f32x4*)g_final)[lane + 64 * j]; xr[64 * j] = v[j] * rs * g; }
    }
}

extern "C" void kernel_launch(void* const* d_in, const int* in_sizes, int n_in, void* d_out, int out_size, void* d_ws, size_t ws_size, hipStream_t stream) {
    static int grid = 0;
    if (grid == 0) {
        if (n_in != 14 || out_size != M * DM || ws_size < WS_END) { fprintf(stderr, "kernel_launch: unexpected shapes (n_in %d out %d ws %zu)\n", n_in, out_size, ws_size); grid = -1; return; }
        int dev = 0, cus = 0, per_cu = 0;
        hipGetDevice(&dev); hipDeviceGetAttribute(&cus, hipDeviceAttributeMultiprocessorCount, dev);
        hipFuncSetAttribute((const void*)hymba_fwd, hipFuncAttributeMaxDynamicSharedMemorySize, LDS_BYTES);
        hipOccupancyMaxActiveBlocksPerMultiprocessor(&per_cu, (const void*)hymba_fwd, 512, LDS_BYTES);
        if (per_cu < 1) { fprintf(stderr, "kernel_launch: occupancy query says %d blocks per CU\n", per_cu); per_cu = 1; }
        (void)hipGetLastError();
        grid = cus * 1;
    }
    if (grid < 0) return;
    Args a{};
    for (int i = 0; i < 14; ++i) a.in[i] = (const float*)d_in[i];
    a.out = (float*)d_out; a.ws = (unsigned char*)d_ws;
    void* args[] = {&a};
    hipError_t e = hipLaunchCooperativeKernel((const void*)hymba_fwd, dim3(grid), dim3(512), args, LDS_BYTES, stream);
    if (e != hipSuccess) fprintf(stderr, "cooperative launch failed: %s (grid %d)\n", hipGetErrorString(e), grid);
}
```

```cpp
#include <hip/hip_runtime.h>
#include <hip/hip_cooperative_groups.h>
#include <cstdio>
#include <cstdint>
namespace cg = cooperative_groups;
namespace pg8 {
#define PG8_LAS __attribute__((address_space(3)))
typedef unsigned short bf16_t;
typedef short bf16x8 __attribute__((ext_vector_type(8)));
typedef float f32x4 __attribute__((ext_vector_type(4)));
typedef unsigned u32x4 __attribute__((ext_vector_type(4)));
constexpr int BM = 256, BK = 64, HALF = 128, HTB = HALF * BK * 2  , STAGE_BYTES = 8 * HTB, NXCD = 8, WGM = 8;

__host__ __device__ __forceinline__ int lds_byte(int r, int c) { const int st = (r >> 4) * 2 + (c >> 5), rr = r & 15, cc = c & 31, ob = rr * 64 + cc * 2; return st * 1024 + (ob ^ (((ob >> 9) & 1) << 5)); }
__host__ __device__ __forceinline__ void stage_rc(int b, int& R, int& C) { const int st = b / 1024, sb = b % 1024, swz = sb ^ (((sb >> 9) & 1) << 5); R = (st >> 1) * 16 + swz / 64; C = (st & 1) * 32 + (swz % 64) / 2; }
__host__ __device__ __forceinline__ int perm32(int rho) { const int n = rho >> 4, i = rho & 15; return 8 * (i >> 2) + 4 * n + (i & 3); }

struct Unit { int pm, pn; };
struct Gemm { const bf16_t* A; const bf16_t* Bt; int M, N, K; };

struct StaticOrder {
    int nM, nN, nwg, G, c;
    __host__ __device__ void init(int M, int N, int G_, int c_) { nM = M / BM; nN = N / BM; nwg = nM * nN; G = G_; c = c_; }
    __host__ __device__ bool next(int i, Unit& u) const {
        const long L = (long)i * G + c; if (L >= nwg) return false;
        int wgid = (int)L; { const int q = nwg / NXCD, r = nwg % NXCD, xcd = wgid % NXCD, off = wgid / NXCD; wgid = (xcd < r ? xcd * (q + 1) : r * (q + 1) + (xcd - r) * q) + off; }
        const int nig = WGM * nN, gid = wgid / nig, fm = gid * WGM, gsz = (nM - fm) < WGM ? (nM - fm) : WGM;
        u.pm = fm + ((wgid % nig) % gsz); u.pn = (wgid % nig) / gsz; return true;
    }
    __device__ __forceinline__ void a_ready(const Unit&) const {}
    __device__ __forceinline__ void done(const Unit&) const {}
};

__device__ __forceinline__ unsigned cvt_pk_bf16(float lo, float hi) { unsigned r; asm volatile("v_cvt_pk_bf16_f32 %0, %1, %2" : "=v"(r) : "v"(lo), "v"(hi)); return r; }
typedef float f32x2 __attribute__((ext_vector_type(2)));
template <class Epi, class Sched, bool ALIGN_EPI = false, bool SP2 = false>
__device__ __forceinline__ void gemm_phase(PG8_LAS unsigned char* lds, const Gemm g, const Sched& S, const Epi& E) {
    const int tid = threadIdx.x, wid = __builtin_amdgcn_readfirstlane(tid >> 6), lane = tid & 63, wr = wid >> 2, wc = wid & 3, fr = lane & 15, fq = lane >> 4;
    const int K = g.K, nt = K / BK;
    unsigned voffA[2], voffB[2];
#pragma unroll
    for (int i = 0; i < 2; ++i) { int R, C; stage_rc(tid * 16 + i * 8192, R, C); const int Rb = Epi::PERM ? ((R & ~31) + perm32(R & 31)) : R;
        voffA[i] = (unsigned)(R * K + C) * 2u; voffB[i] = (unsigned)(Rb * K + C) * 2u; }
    const size_t kstep = (size_t)(BK * 2);
    const size_t hstep = (size_t)HALF * K * 2;
    const size_t tstep = 2 * hstep;
    const unsigned ldsw = (unsigned)wid * 1024u;
    const int aoff = lds_byte(wr * 64 + fr, fq * 8), boff = lds_byte(wc * 32 + fr, fq * 8);
#define PG8_SA(b, h) (((b) * 2 + (h)) * HTB)
#define PG8_SB(b, h) ((4 + (b) * 2 + (h)) * HTB)
#define PG8_STAGE(bufoff, gbase, voff) do { _Pragma("unroll") for (int _i = 0; _i < 2; ++_i) \
        __builtin_amdgcn_global_load_lds((const unsigned*)((const char*)(gbase) + (voff)[_i]), (PG8_LAS unsigned*)(lds + (bufoff) + ldsw + _i * 8192), 16, 0, 0); } while (0)
#define PG8_LDA(dst, b, h) do { _Pragma("unroll") for (int m = 0; m < 4; ++m) _Pragma("unroll") for (int k = 0; k < 2; ++k) dst[m][k] = *(const PG8_LAS bf16x8*)(lds + PG8_SA(b, h) + aoff + m * 2048 + k * 1024); } while (0)
#define PG8_LDB(dst, b, h) do { _Pragma("unroll") for (int n = 0; n < 2; ++n) _Pragma("unroll") for (int k = 0; k < 2; ++k) dst[n][k] = *(const PG8_LAS bf16x8*)(lds + PG8_SB(b, h) + boff + n * 2048 + k * 1024); } while (0)
#define PG8_MMA(ai, bj, At, Bt) do { __builtin_amdgcn_s_setprio(1); _Pragma("unroll") for (int m = 0; m < 4; ++m) _Pragma("unroll") for (int n = 0; n < 2; ++n) _Pragma("unroll") for (int k = 0; k < 2; ++k) \
        acc[ai][bj][m][n] = __builtin_amdgcn_mfma_f32_16x16x32_bf16(Bt[n][k], At[m][k], acc[ai][bj][m][n], 0, 0, 0); __builtin_amdgcn_s_setprio(0); } while (0)
#define PG8_WAIT_V(n) asm volatile("s_waitcnt vmcnt(" #n ")" ::: "memory")
#define PG8_WAIT_L(n) asm volatile("s_waitcnt lgkmcnt(" #n ")" ::: "memory")
#define PG8_BAR __builtin_amdgcn_s_barrier()
#define PG8_SCHED __builtin_amdgcn_sched_barrier(0)
    Unit cur, nxt; int ui = 0;
    if (!S.next(0, cur)) return;
    f32x4 acc[2][2][4][2];
#pragma unroll
    for (int a = 0; a < 2; ++a)
#pragma unroll
        for (int b = 0; b < 2; ++b)
#pragma unroll
            for (int m = 0; m < 4; ++m)
#pragma unroll
                for (int n = 0; n < 2; ++n) acc[a][b][m][n] = (f32x4){0.f, 0.f, 0.f, 0.f};
    bf16x8 At[4][2], B0[2][2], B1[2][2];
    const char* cA = (const char*)g.A + (size_t)cur.pm * tstep; const char* cB = (const char*)g.Bt + (size_t)cur.pn * tstep;
    S.a_ready(cur);
    if constexpr (SP2) {
        PG8_STAGE(PG8_SB(0, 0), cB, voffB); PG8_STAGE(PG8_SB(0, 1), cB + hstep, voffB); PG8_STAGE(PG8_SA(0, 0), cA, voffA); PG8_STAGE(PG8_SA(0, 1), cA + hstep, voffA);
        if (wr == 1) PG8_BAR;
        PG8_WAIT_V(2); PG8_BAR;
        PG8_STAGE(PG8_SB(1, 0), cB + kstep, voffB); PG8_STAGE(PG8_SA(1, 0), cA + kstep, voffA); PG8_STAGE(PG8_SB(1, 1), cB + hstep + kstep, voffB);
        PG8_WAIT_V(6); PG8_BAR;
    } else {
        PG8_STAGE(PG8_SB(0, 0), cB, voffB); PG8_STAGE(PG8_SA(0, 0), cA, voffA); PG8_STAGE(PG8_SB(0, 1), cB + hstep, voffB); PG8_STAGE(PG8_SA(0, 1), cA + hstep, voffA);
        if (wr == 1) PG8_BAR;
        PG8_WAIT_V(4); PG8_BAR;
        PG8_STAGE(PG8_SB(1, 0), cB + kstep, voffB); PG8_STAGE(PG8_SA(1, 0), cA + kstep, voffA); PG8_STAGE(PG8_SB(1, 1), cB + hstep + kstep, voffB);
        PG8_WAIT_V(6); PG8_BAR;
    }
    for (;;) {
        const bool has_next = S.next(ui + 1, nxt);
        const char* nA = has_next ? (const char*)g.A + (size_t)nxt.pm * tstep : cA; const char* nB = has_next ? (const char*)g.Bt + (size_t)nxt.pn * tstep : cB;
        for (int t = 0; t < nt; t += 2) {
            const bool last = (t == nt - 2);
            const char* a1 = cA + (size_t)(t + 1) * kstep;
            const char* a2 = last ? nA : cA + (size_t)(t + 2) * kstep; const char* b2 = last ? nB : cB + (size_t)(t + 2) * kstep;
            const char* a3 = a2 + kstep; const char* b3 = b2 + kstep;
            if (last && has_next) S.a_ready(nxt);
            if constexpr (SP2) {
            PG8_LDB(B0, 0, 0); PG8_LDB(B1, 0, 1); PG8_SCHED; PG8_LDA(At, 0, 0); PG8_STAGE(PG8_SA(1, 1), a1 + hstep, voffA);
            PG8_WAIT_V(8); PG8_WAIT_L(0); PG8_BAR; PG8_MMA(0, 0, At, B0); PG8_MMA(0, 1, At, B1); PG8_BAR; PG8_SCHED;
            PG8_LDA(At, 0, 1); PG8_STAGE(PG8_SB(0, 0), b2, voffB); PG8_STAGE(PG8_SB(0, 1), b2 + hstep, voffB); PG8_STAGE(PG8_SA(0, 0), a2, voffA);
            PG8_WAIT_V(8); PG8_WAIT_L(0); PG8_BAR; PG8_MMA(1, 0, At, B0); PG8_MMA(1, 1, At, B1); PG8_BAR; PG8_SCHED;
            PG8_LDB(B0, 1, 0); PG8_LDB(B1, 1, 1); PG8_SCHED; PG8_LDA(At, 1, 0); PG8_STAGE(PG8_SA(0, 1), a2 + hstep, voffA);
            PG8_WAIT_V(8); PG8_WAIT_L(0); PG8_BAR; PG8_MMA(0, 0, At, B0); PG8_MMA(0, 1, At, B1); PG8_BAR; PG8_SCHED;
            PG8_LDA(At, 1, 1); PG8_STAGE(PG8_SB(1, 0), b3, voffB); PG8_STAGE(PG8_SB(1, 1), b3 + hstep, voffB); PG8_STAGE(PG8_SA(1, 0), a3, voffA);
            PG8_WAIT_V(8); PG8_WAIT_L(0); PG8_BAR; PG8_MMA(1, 0, At, B0); PG8_MMA(1, 1, At, B1); PG8_BAR; PG8_SCHED;
            } else {
            PG8_LDB(B0, 0, 0); PG8_SCHED; PG8_LDA(At, 0, 0); PG8_STAGE(PG8_SA(1, 1), a1 + hstep, voffA);
            PG8_WAIT_L(8); PG8_BAR; PG8_WAIT_L(0); PG8_MMA(0, 0, At, B0); PG8_BAR; PG8_SCHED;
            PG8_LDB(B1, 0, 1); PG8_STAGE(PG8_SB(0, 0), b2, voffB);
            PG8_BAR; PG8_WAIT_L(0); PG8_MMA(0, 1, At, B1); PG8_BAR;
            PG8_LDA(At, 0, 1); PG8_STAGE(PG8_SA(0, 0), a2, voffA);
            PG8_BAR; PG8_WAIT_L(0); PG8_MMA(1, 0, At, B0); PG8_BAR; PG8_SCHED;
            PG8_STAGE(PG8_SB(0, 1), b2 + hstep, voffB);
            PG8_WAIT_V(6); PG8_BAR; PG8_MMA(1, 1, At, B1); PG8_BAR;
            PG8_LDB(B0, 1, 0); PG8_SCHED; PG8_LDA(At, 1, 0); PG8_STAGE(PG8_SA(0, 1), a2 + hstep, voffA);
            PG8_WAIT_L(8); PG8_BAR; PG8_WAIT_L(0); PG8_MMA(0, 0, At, B0); PG8_BAR; PG8_SCHED;
            PG8_LDB(B1, 1, 1); PG8_STAGE(PG8_SB(1, 0), b3, voffB);
            PG8_BAR; PG8_WAIT_L(0); PG8_MMA(0, 1, At, B1); PG8_BAR;
            PG8_LDA(At, 1, 1); PG8_STAGE(PG8_SA(1, 0), a3, voffA);
            PG8_BAR; PG8_WAIT_L(0); PG8_MMA(1, 0, At, B0); PG8_BAR; PG8_SCHED;
            PG8_STAGE(PG8_SB(1, 1), b3 + hstep, voffB);
            PG8_WAIT_V(6); PG8_BAR; PG8_MMA(1, 1, At, B1); PG8_BAR;
            }
        }
        if constexpr (ALIGN_EPI) { if (wr == 0) PG8_BAR; }
        if constexpr (!Epi::AFTER_DRAIN) { E(acc, cur, wr, wc, fr, fq); S.done(cur); }
        if (!has_next) break;
#pragma unroll
        for (int a = 0; a < 2; ++a)
#pragma unroll
            for (int b = 0; b < 2; ++b)
#pragma unroll
                for (int m = 0; m < 4; ++m)
#pragma unroll
                    for (int n = 0; n < 2; ++n) acc[a][b][m][n] = (f32x4){0.f, 0.f, 0.f, 0.f};
        cur = nxt; cA = nA; cB = nB; ++ui;
        if constexpr (ALIGN_EPI) { if (wr == 1) PG8_BAR; }
    }
    PG8_WAIT_V(0);
    if constexpr (!ALIGN_EPI) { if (wr == 0) PG8_BAR; }
    PG8_BAR;
    if constexpr (Epi::AFTER_DRAIN) { E.fused(acc, cur, wr, wc, fr, fq, lds, wid, lane); S.done(cur); }
#undef PG8_SA
#undef PG8_SB
#undef PG8_STAGE
#undef PG8_LDA
#undef PG8_LDB
#undef PG8_MMA
#undef PG8_WAIT_V
#undef PG8_WAIT_L
#undef PG8_BAR
#undef PG8_SCHED
}
}
namespace pg8 {
typedef unsigned u32x2 __attribute__((ext_vector_type(2)));
constexpr int LD_QKV = 2304, LD_D = 1024, LD_FF = 2816;
constexpr float RMS_EPS = 1e-5f;

struct EpiQKV {
    static constexpr bool PERM = true, AFTER_DRAIN = false;
    bf16_t* O; const float* bias; const float* ropeC; const float* ropeS;
    __device__ __forceinline__ void operator()(const f32x4 (&acc)[2][2][4][2], const Unit& u, int wr, int wc, int fr, int fq) const {
        const int row0 = u.pm * BM + wr * 64 + fr;
        const float sc = (u.pn < 2 || u.pn == 3 || u.pn == 4) ? 0.125f : 1.0f;
#pragma unroll
        for (int bj = 0; bj < 2; ++bj) {
            const bool rope = (u.pn < 2) || (u.pn == 2 && bj == 0);
            if (rope) {
                const int dl = 16 * (wc & 1) + 4 * fq, colh = u.pn * BM + bj * HALF + 64 * (wc >> 1);
                const f32x4 b0 = *(const f32x4*)(bias + colh + dl), b1 = *(const f32x4*)(bias + colh + 32 + dl);
#pragma unroll
                for (int ai = 0; ai < 2; ++ai)
#pragma unroll
                    for (int m = 0; m < 4; ++m) { const int r = row0 + ai * HALF + m * 16, pos = r & 8191;
                        const f32x4 cs = *(const f32x4*)(ropeC + pos * 32 + dl), sn = *(const f32x4*)(ropeS + pos * 32 + dl);
                        const f32x4 t1 = acc[ai][bj][m][0] + b0, t2 = acc[ai][bj][m][1] + b1;
                        const f32x4 o1 = (t1 * cs - t2 * sn) * sc, o2 = (t1 * sn + t2 * cs) * sc;
                        bf16_t* p = O + (size_t)r * LD_QKV + colh + dl;
                        u32x2 w1; w1.x = cvt_pk_bf16(o1[0], o1[1]); w1.y = cvt_pk_bf16(o1[2], o1[3]); *(u32x2*)p = w1;
                        u32x2 w2; w2.x = cvt_pk_bf16(o2[0], o2[1]); w2.y = cvt_pk_bf16(o2[2], o2[3]); *(u32x2*)(p + 32) = w2; }
            } else {
                const int col0 = u.pn * BM + bj * HALF + wc * 32 + 8 * fq;
                const f32x4 b0 = *(const f32x4*)(bias + col0), b1 = *(const f32x4*)(bias + col0 + 4);
#pragma unroll
                for (int ai = 0; ai < 2; ++ai)
#pragma unroll
                    for (int m = 0; m < 4; ++m) { const f32x4 v0 = (acc[ai][bj][m][0] + b0) * sc, v1 = (acc[ai][bj][m][1] + b1) * sc;
                        u32x4 w; w.x = cvt_pk_bf16(v0[0], v0[1]); w.y = cvt_pk_bf16(v0[2], v0[3]); w.z = cvt_pk_bf16(v1[0], v1[1]); w.w = cvt_pk_bf16(v1[2], v1[3]);
                        *(u32x4*)(O + (size_t)(row0 + ai * HALF + m * 16) * LD_QKV + col0) = w; }
            }
        }
    }
};
struct EpiRes1 {
    static constexpr bool PERM = false, AFTER_DRAIN = false;
    const float* X; float* X1; bf16_t* X1B; float* ssq;
    __device__ __forceinline__ void operator()(const f32x4 (&acc)[2][2][4][2], const Unit& u, int wr, int wc, int fr, int fq) const {
        const int row0 = u.pm * BM + wr * 64 + fr, col0 = u.pn * BM + wc * 32 + 4 * fq;
#pragma unroll
        for (int ai = 0; ai < 2; ++ai)
#pragma unroll
            for (int m = 0; m < 4; ++m) { const int r = row0 + ai * HALF + m * 16; const size_t off = (size_t)r * LD_D + col0; float ss = 0.f;
#pragma unroll
                for (int bj = 0; bj < 2; ++bj)
#pragma unroll
                    for (int n = 0; n < 2; ++n) { const f32x4 xv = *(const f32x4*)(X + off + bj * HALF + n * 16); const f32x4 o = xv + acc[ai][bj][m][n];
                        *(f32x4*)(X1 + off + bj * HALF + n * 16) = o; u32x2 w; w.x = cvt_pk_bf16(o[0], o[1]); w.y = cvt_pk_bf16(o[2], o[3]);
                        *(u32x2*)(X1B + off + bj * HALF + n * 16) = w; ss += (o[0] * o[0] + o[1] * o[1]) + (o[2] * o[2] + o[3] * o[3]); }
                ss += __shfl_xor(ss, 16); ss += __shfl_xor(ss, 32);
                if (fq == 0) atomicAdd(ssq + r, ss);
                if (m & 1) asm volatile("" ::: "memory"); }
    }
};
struct EpiSwiGLU {
    static constexpr bool PERM = true, AFTER_DRAIN = false;
    bf16_t* ACT; const float* ssq;
    __device__ __forceinline__ void operator()(const f32x4 (&acc)[2][2][4][2], const Unit& u, int wr, int wc, int fr, int fq) const {
        const int row0 = u.pm * BM + wr * 64 + fr, col0 = u.pn * HALF + wc * 32 + 8 * fq;
#pragma unroll
        for (int ai = 0; ai < 2; ++ai)
#pragma unroll
            for (int m = 0; m < 4; ++m) { const int r = row0 + ai * HALF + m * 16;
                const float rs = 1.0f / sqrtf(ssq[r] * (1.0f / 1024.0f) + RMS_EPS);
                float a[8];
#pragma unroll
                for (int n = 0; n < 2; ++n)
#pragma unroll
                    for (int e = 0; e < 4; ++e) { const float g = acc[ai][0][m][n][e] * rs, up = acc[ai][1][m][n][e] * rs;
                        const float sg = g * __builtin_amdgcn_rcpf(1.0f + __builtin_amdgcn_exp2f(-1.4426950408889634f * g)); a[n * 4 + e] = sg * up; }
                u32x4 w; w.x = cvt_pk_bf16(a[0], a[1]); w.y = cvt_pk_bf16(a[2], a[3]); w.z = cvt_pk_bf16(a[4], a[5]); w.w = cvt_pk_bf16(a[6], a[7]);
                *(u32x4*)(ACT + (size_t)r * LD_FF + col0) = w; }
    }
};
struct EpiRes2 {
    static constexpr bool PERM = false, AFTER_DRAIN = false;
    float* X1;
    __device__ __forceinline__ void operator()(const f32x4 (&acc)[2][2][4][2], const Unit& u, int wr, int wc, int fr, int fq) const {
        const int row0 = u.pm * BM + wr * 64 + fr, col0 = u.pn * BM + wc * 32 + 4 * fq;
#pragma unroll
        for (int ai = 0; ai < 2; ++ai)
#pragma unroll
            for (int m = 0; m < 4; ++m) { const size_t off = (size_t)(row0 + ai * HALF + m * 16) * LD_D + col0;
#pragma unroll
                for (int bj = 0; bj < 2; ++bj)
#pragma unroll
                    for (int n = 0; n < 2; ++n) { float* p = X1 + off + bj * HALF + n * 16; const f32x4 xv = *(const f32x4*)p; *(f32x4*)p = xv + acc[ai][bj][m][n]; }
                if (m & 1) asm volatile("" ::: "memory"); }
    }
};
}
#define GAS __attribute__((address_space(1)))
#define LAS __attribute__((address_space(3)))
typedef unsigned short bf16;
typedef unsigned v4u __attribute__((ext_vector_type(4)));
typedef float f32x4 __attribute__((ext_vector_type(4)));
constexpr int BATCH = 8, SEQ = 8192, DM = 1024, M = BATCH * SEQ, NP = 2304, FF = 2816, NGU = 2 * FF;
constexpr float EPS = 1e-5f;
constexpr size_t MiB = 1u << 20;
constexpr size_t WS_SSQ1 = 0, WS_BIAS = 512 * 1024, WS_ROPE = 1 * MiB;
constexpr size_t WS_W1 = 4 * MiB, WS_W2 = 9 * MiB, WS_W3 = 11 * MiB, WS_W4 = 22 * MiB;
constexpr size_t WS_XN = 32 * MiB;
constexpr size_t WS_QKV = 160 * MiB;
constexpr size_t WS_OA = 448 * MiB, WS_OB = 512 * MiB;
constexpr size_t WS_LSE = 704 * MiB;
constexpr size_t WS_X1B = 160 * MiB;
constexpr size_t WS_ACT = 288 * MiB;
constexpr size_t WS_END = 712 * MiB;
constexpr int BIAS_LD = 132;
constexpr int LDS_BYTES = 147456, LDSCTL_OFF = 131072;
constexpr size_t WS_BAR = 256 * 1024;

__device__ __forceinline__ unsigned pk2(float lo, float hi) { return pg8::cvt_pk_bf16(lo, hi); }
__device__ __forceinline__ float bflo(unsigned w) { return __uint_as_float(w << 16); }
__device__ __forceinline__ float bfhi(unsigned w) { return __uint_as_float(w & 0xffff0000u); }
__device__ __forceinline__ float wave_sum(float v) {
#pragma unroll
    for (int o = 1; o < 64; o <<= 1) v += __shfl_xor(v, o);
    return v;
}
__device__ __forceinline__ int w1_src_col(int c) {
    if (c >= 640) return c;
    const int idx = c & 127, wc = idx >> 5, w = idx & 31, fq = w >> 3, n = (w >> 2) & 1, e = w & 3;
    return (c & ~127) + 64 * (wc >> 1) + 16 * (wc & 1) + 4 * fq + e + 32 * n;
}
template <bool MAP1>
__device__ __forceinline__ void tr_item(const float* W, int K, int N, int k0, int n0, bf16* WT, int r0, LAS float* scr, int lane, const float* gk) {
    const int scol = MAP1 ? w1_src_col(r0 + (lane & 31)) : n0 + (lane & 31);
#pragma unroll 8
    for (int i = 0; i < 32; ++i) { const int kk = 2 * i + (lane >> 5); float v = W[(size_t)(k0 + kk) * N + scol]; if (gk) v *= gk[k0 + kk]; scr[kk * 33 + (lane & 31)] = v; }
    asm volatile("s_waitcnt lgkmcnt(0)" ::: "memory");
    const int c = lane & 7;
#pragma unroll
    for (int j = 0; j < 4; ++j) { const int n = (lane >> 3) + 8 * j; const LAS float* s = scr + (8 * c) * 33 + n;
        v4u o; o.x = pk2(s[0 * 33], s[1 * 33]); o.y = pk2(s[2 * 33], s[3 * 33]); o.z = pk2(s[4 * 33], s[5 * 33]); o.w = pk2(s[6 * 33], s[7 * 33]);
        *(v4u*)(WT + (size_t)(r0 + n) * K + k0 + 8 * c) = o; }
    asm volatile("s_waitcnt lgkmcnt(0)" ::: "memory");
}
__device__ __forceinline__ int t5_bucket(int dist) {
    if (dist < 16) return dist;
    const float df = (float)dist;
    int large = 16 + (int)((logf(df / 16.0f) / 4.852030263919617f) * 16.0f);
    return large < 31 ? large : 31;
}

#define XB_TMO      128
#define XB_XCNT(j)  (256  + 64 * (j))
#define XB_XSUB(j)  (1280 + 64 * (j))
#define XB_XGEN(j)  (2304 + 64 * (j))
#define XB_TOP      3328
#define XB_TOPGEN   3392
#define XCD_BAR_WORDS 3456
#define XB_SPIN_CAP (1u << 18)

__device__ __forceinline__ unsigned xb_ld(unsigned* p)              { return __hip_atomic_load(p, __ATOMIC_RELAXED, __HIP_MEMORY_SCOPE_AGENT); }
__device__ __forceinline__ unsigned xb_add(unsigned* p, unsigned v) { return __hip_atomic_fetch_add(p, v, __ATOMIC_RELAXED, __HIP_MEMORY_SCOPE_AGENT); }
__device__ __forceinline__ unsigned xb_xcc_id() { return (unsigned)__builtin_amdgcn_s_getreg((3 << 11) | 20) & 0xFu; }
#define XB_SPIN(cond, bar) do { unsigned _sp = 0; while (cond) { __builtin_amdgcn_s_sleep(1); \
    if ((++_sp & 255u) == 0u) { if (xb_ld(&(bar)[XB_TMO])) break; if (_sp > XB_SPIN_CAP) { atomicAdd(&(bar)[XB_TMO], 1u); break; } } } } while (0)

struct XcdBarrier {
    unsigned* bar; unsigned x;
    volatile LAS unsigned* st;
};

__device__ __forceinline__ XcdBarrier xcd_barrier_post(unsigned* bar, volatile LAS unsigned* st) {
    XcdBarrier b; b.bar = bar; b.x = xb_xcc_id(); b.st = st;
    if (threadIdx.x == 0) (void)xb_add(&bar[XB_XCNT(b.x)], 1u);
    return b;
}
__device__ __forceinline__ void xcd_barrier_complete(unsigned* bar, unsigned x, unsigned& nloc, unsigned& nx) {
    const unsigned G = gridDim.x * gridDim.y * gridDim.z;
    unsigned sum, cnt, mine, sp = 0u;
    for (;;) {
        sum = 0u; cnt = 0u; mine = 0u;
#pragma unroll
        for (unsigned j = 0; j < 16; ++j) { const unsigned c = xb_ld(&bar[XB_XCNT(j)]); sum += c; cnt += (c > 0u) ? 1u : 0u; mine = (j == x) ? c : mine; }
        if (sum == G) break;
        __builtin_amdgcn_s_sleep(1);
        if ((++sp & 255u) == 0u) { if (xb_ld(&bar[XB_TMO])) break; if (sp > XB_SPIN_CAP) { atomicAdd(&bar[XB_TMO], 1u); break; } }
    }
    nloc = mine > 0u ? mine : 1u; nx = cnt > 0u ? cnt : 1u;
}

__device__ __forceinline__ void xcd_barrier(const XcdBarrier& b) {
    asm volatile("s_waitcnt vmcnt(0)" ::: "memory");
    __syncthreads();
    if (threadIdx.x == 0) {
        unsigned* bar = b.bar;
        __builtin_amdgcn_s_waitcnt(0);
        unsigned nloc = b.st[0], nx = b.st[1];
        if (nloc == 0u) { xcd_barrier_complete(bar, b.x, nloc, nx); b.st[0] = nloc; b.st[1] = nx; }
        const unsigned old = xb_add(&bar[XB_XSUB(b.x)], 1u);
        const unsigned gen = old / nloc;
        if (old + 1u == (gen + 1u) * nloc) {
            __builtin_amdgcn_fence(__ATOMIC_RELEASE, "agent");
            asm volatile("s_waitcnt vmcnt(0)" ::: "memory");
            const unsigned og = xb_add(&bar[XB_TOP], 1u);
            const unsigned tg = og / nx;
            if (og + 1u == (tg + 1u) * nx) xb_add(&bar[XB_TOPGEN], 1u);
            else XB_SPIN(xb_ld(&bar[XB_TOPGEN]) == tg, bar);
            __builtin_amdgcn_fence(__ATOMIC_ACQUIRE, "agent");
            xb_add(&bar[XB_XGEN(b.x)], 1u);
            asm volatile("s_waitcnt vmcnt(0)" ::: "memory");
        } else {
            XB_SPIN(xb_ld(&bar[XB_XGEN(b.x)]) == gen, bar);
            __builtin_amdgcn_fence(__ATOMIC_ACQUIRE, "agent");
            asm volatile("s_waitcnt vmcnt(0)" ::: "memory");
        }
    }
    __syncthreads();
}

struct Args { const float* in[14]; float* out; unsigned char* ws; };

__device__ __forceinline__ void naive_attn(const bf16* QKV, bf16* OA, bf16* OB, float* LSE, const float* sinks, const float* biasT, int gt, int NGT) {
    for (int it = gt; it < 4 * 8 * M; it += NGT) {
        const int m = it & (M - 1), ch = it >> 16, c = ch >> 3, h = ch & 7, pos = m & (SEQ - 1);
        int qcol, kcol, vcol, dil, nb;
        if (c == 0) { qcol = h * 64; kcol = 512 + (h >> 2) * 64; vcol = 640 + (h >> 2) * 64; dil = 1; nb = 127; }
        else { qcol = 768 + h * 64; kcol = 1280 + h * 64; vcol = 1792 + h * 64; dil = (c == 1) ? 1 : (c == 2 ? 4 : 16); nb = 128; }
        float q[64], o[64];
        { const v4u* qp = (const v4u*)(QKV + (size_t)m * NP + qcol);
#pragma unroll
          for (int j = 0; j < 8; ++j) { const v4u w = qp[j]; q[8*j+0] = bflo(w.x); q[8*j+1] = bfhi(w.x); q[8*j+2] = bflo(w.y); q[8*j+3] = bfhi(w.y); q[8*j+4] = bflo(w.z); q[8*j+5] = bfhi(w.z); q[8*j+6] = bflo(w.w); q[8*j+7] = bfhi(w.w); } }
#pragma unroll
        for (int j = 0; j < 64; ++j) o[j] = 0.f;
        float mx = (c == 0) ? sinks[h] : -1e30f, l = (c == 0) ? 1.f : 0.f;
        const float* bt = biasT + ((c > 0 ? c - 1 : 0) * 8 + h) * BIAS_LD;
        for (int d = 0; d <= nb; ++d) {
            const int kp = pos - d * dil; if (kp < 0) break;
            const bf16* row = QKV + (size_t)(m - d * dil) * NP;
            const v4u* kr = (const v4u*)(row + kcol); float s = 0.f;
#pragma unroll
            for (int j = 0; j < 8; ++j) { const v4u w = kr[j];
                s += q[8*j+0] * bflo(w.x) + q[8*j+1] * bfhi(w.x) + q[8*j+2] * bflo(w.y) + q[8*j+3] * bfhi(w.y) + q[8*j+4] * bflo(w.z) + q[8*j+5] * bfhi(w.z) + q[8*j+6] * bflo(w.w) + q[8*j+7] * bfhi(w.w); }
            if (c) s += bt[d];
            const float mn = fmaxf(mx, s), al = __expf(mx - mn), p = __expf(s - mn);
            l = l * al + p; mx = mn;
            const v4u* vr = (const v4u*)(row + vcol);
#pragma unroll
            for (int j = 0; j < 8; ++j) { const v4u w = vr[j];
                o[8*j+0] = o[8*j+0] * al + p * bflo(w.x); o[8*j+1] = o[8*j+1] * al + p * bfhi(w.x); o[8*j+2] = o[8*j+2] * al + p * bflo(w.y); o[8*j+3] = o[8*j+3] * al + p * bfhi(w.y);
                o[8*j+4] = o[8*j+4] * al + p * bflo(w.z); o[8*j+5] = o[8*j+5] * al + p * bfhi(w.z); o[8*j+6] = o[8*j+6] * al + p * bflo(w.w); o[8*j+7] = o[8*j+7] * al + p * bfhi(w.w); }
        }
        const float inv = 1.0f / l;
        bf16* op = (c == 0) ? (OA + (size_t)m * 512 + h * 64) : (OB + (size_t)(c - 1) * M * 512 + (size_t)m * 512 + h * 64);
#pragma unroll
        for (int j = 0; j < 8; ++j) { v4u w; w.x = pk2(o[8*j+0] * inv, o[8*j+1] * inv); w.y = pk2(o[8*j+2] * inv, o[8*j+3] * inv); w.z = pk2(o[8*j+4] * inv, o[8*j+5] * inv); w.w = pk2(o[8*j+6] * inv, o[8*j+7] * inv); ((v4u*)op)[j] = w; }
        if (c) LSE[(size_t)(c - 1) * M * 8 + (size_t)m * 8 + h] = mx + logf(l);
    }
}

namespace att {
typedef short bf16x8 __attribute__((ext_vector_type(8)));
typedef short s16x4 __attribute__((ext_vector_type(4)));
typedef float f32x16 __attribute__((ext_vector_type(16)));
typedef unsigned u32x2 __attribute__((ext_vector_type(2)));
typedef short v4i16_t __attribute__((ext_vector_type(4)));
__device__ __forceinline__ int crow(int i, int hi) { return (i & 3) + 8 * (i >> 2) + 4 * hi; }
__device__ __forceinline__ s16x4 vtr(LAS const char* p) { return __builtin_bit_cast(s16x4, __builtin_amdgcn_ds_read_tr16_b64_v4i16((LAS v4i16_t*)p)); }
constexpr int CTAB_OFF = 0, CTAB_BYTES = 20480, KWIN_OFF = 20480, WIN_BYTES = 49152, VWIN_OFF = KWIN_OFF + WIN_BYTES;
constexpr float LOG2E = 1.4426950408889634f;

template <int C>
__device__ __forceinline__ void attn_wg(const bf16* QKV, bf16* Oout, float* LSEout, int b, int h, int dil, float sink, const float* bias_g  ,
                                        LAS unsigned char* ldsl, int tid, int lane, int wave) {
    constexpr int NB = C == 0 ? 127 : 128;
    const int r = lane & 31, hi = lane >> 5;
    const int qcol = C == 0 ? h * 64 : 768 + h * 64, kcol = C == 0 ? 512 + (h >> 2) * 64 : 1280 + h * 64, vcol = C == 0 ? 640 + (h >> 2) * 64 : 1792 + h * 64;
    LAS float* ctab = (LAS float*)(ldsl + CTAB_OFF);
    LAS char* kwin = (LAS char*)(ldsl + KWIN_OFF);
    LAS char* vwin = (LAS char*)(ldsl + VWIN_OFF);
    for (int idx = tid; idx < 5 * 16 * 64; idx += 512) {
        const int e = idx & 3, ln = (idx >> 2) & 63, i4 = (idx >> 8) & 3, t = idx >> 10, i = 4 * i4 + e;
        const int delta = 128 - 32 * t + (ln & 31) - crow(i, ln >> 5);
        float v = -INFINITY;
        if (delta >= 0 && delta <= NB) v = C == 0 ? 0.f : bias_g[delta];
        ctab[idx] = v;
    }
    const int upr = 32 / dil;
    const size_t seq0 = (size_t)b * SEQ;
#define ATT_DMA_K(res_, u0_) do { _Pragma("unroll") for (int j_ = 0; j_ < 6; ++j_) { const int pc_ = wave * 6 + j_; const int kt_ = 8 * (pc_ & 3) + (lane >> 3); \
        int sp_ = (u0_) - 128 + 32 * (pc_ >> 2) + kt_; sp_ = sp_ < 0 ? 0 : sp_; const int ch_ = (lane & 7) ^ ((kt_ >> 1) & 7); \
        __builtin_amdgcn_global_load_lds((const unsigned*)(QKV + (seq0 + (res_) + (size_t)dil * sp_) * NP + kcol + 8 * ch_), (LAS unsigned*)(kwin + pc_ * 1024), 16, 0, 0); } } while (0)
#define ATT_DMA_V(res_, u0_) do { _Pragma("unroll") for (int j_ = 0; j_ < 6; ++j_) { const int pc_ = wave * 6 + j_; const int jv_ = pc_ & 3; \
        int sp_ = (u0_) - 128 + 32 * (pc_ >> 2) + 16 * (jv_ & 1) + (lane >> 2); sp_ = sp_ < 0 ? 0 : sp_; \
        __builtin_amdgcn_global_load_lds((const unsigned*)(QKV + (seq0 + (res_) + (size_t)dil * sp_) * NP + vcol + 32 * (jv_ >> 1) + 8 * (lane & 3)), (LAS unsigned*)(vwin + pc_ * 1024), 16, 0, 0); } } while (0)
#define ATT_LOAD_Q(res_, u0_) do { const bf16* qp_ = QKV + (seq0 + (res_) + (size_t)dil * ((u0_) + 32 * wave + r)) * NP + qcol + 8 * hi; \
        _Pragma("unroll") for (int ks_ = 0; ks_ < 4; ++ks_) qf[ks_] = *(const bf16x8*)(qp_ + 16 * ks_); } while (0)
    bf16x8 qf[4];
    ATT_DMA_K(0, 0);
    ATT_LOAD_Q(0, 0);
    const int koff = r * 128, kx = (r >> 1) & 7;
    const int vrd = ((lane >> 4) & 1) * 32 + (lane & 3) * 8 + (4 * hi + ((lane & 15) >> 2)) * 64;
    for (int u = 0; u < 32; ++u) {
        const int res = u / upr, u0 = (u % upr) * 256;
        const int l0 = u0 + 32 * wave;
        const int t0 = l0 >= 128 ? 0 : ((128 - l0) >> 5);
        asm volatile("s_waitcnt vmcnt(0)" ::: "memory");
        __syncthreads();
        ATT_DMA_V(res, u0);
        f32x16 S[5];
#pragma unroll
        for (int t = 0; t < 5; ++t) {
            f32x16 acc;
#pragma unroll
            for (int i4 = 0; i4 < 4; ++i4) { const f32x4 cv = *(const LAS f32x4*)(ctab + ((t * 4 + i4) * 64 + lane) * 4); acc[4*i4+0] = cv[0]; acc[4*i4+1] = cv[1]; acc[4*i4+2] = cv[2]; acc[4*i4+3] = cv[3]; }
            const LAS char* kt = kwin + (wave + t) * 4096 + koff;
#pragma unroll
            for (int ks = 0; ks < 4; ++ks) { const bf16x8 kf = *(const LAS bf16x8*)(kt + (((2 * ks + hi) ^ kx) << 4)); acc = __builtin_amdgcn_mfma_f32_32x32x16_bf16(kf, qf[ks], acc, 0, 0, 0); }
            if (t < t0) {
#pragma unroll
                for (int i = 0; i < 16; ++i) acc[i] = -INFINITY;
            }
            S[t] = acc;
        }
        float mx = C == 0 ? sink : -1e30f;
#pragma unroll
        for (int t = 0; t < 5; ++t)
#pragma unroll
            for (int i = 0; i < 16; ++i) mx = fmaxf(mx, S[t][i]);
        mx = fmaxf(mx, __shfl_xor(mx, 32));
        const float mneg = -mx * LOG2E;
        float l = 0.f;
#pragma unroll
        for (int t = 0; t < 5; ++t)
#pragma unroll
            for (int i = 0; i < 16; ++i) { const float p = __builtin_amdgcn_exp2f(__builtin_fmaf(S[t][i], LOG2E, mneg)); S[t][i] = p; l += p; }
        l += __shfl_xor(l, 32);
        if (C == 0) l += __builtin_amdgcn_exp2f(__builtin_fmaf(sink, LOG2E, mneg));
        const size_t rowq = seq0 + res + (size_t)dil * (l0 + r);
        asm volatile("s_waitcnt vmcnt(0)" ::: "memory");
        __syncthreads();
        if (u + 1 < 32) { const int res1 = (u + 1) / upr, u1 = ((u + 1) % upr) * 256; ATT_DMA_K(res1, u1); ATT_LOAD_Q(res1, u1); }
        f32x16 o0 = {}, o1 = {};
#pragma unroll
        for (int t = 0; t < 5; ++t) {
            const LAS char* vb = vwin + (wave + t) * 4096 + vrd;
            bf16x8 pf[2];
#pragma unroll
            for (int s = 0; s < 2; ++s) { v4u w; w.x = pk2(S[t][8*s+0], S[t][8*s+1]); w.y = pk2(S[t][8*s+2], S[t][8*s+3]); w.z = pk2(S[t][8*s+4], S[t][8*s+5]); w.w = pk2(S[t][8*s+6], S[t][8*s+7]);
                pf[s] = __builtin_bit_cast(bf16x8, w); }
#pragma unroll
            for (int s = 0; s < 2; ++s) {
                const s16x4 a0 = vtr(vb + s * 1024), a1 = vtr(vb + s * 1024 + 512);
                const s16x4 c0 = vtr(vb + 2048 + s * 1024), c1 = vtr(vb + 2048 + s * 1024 + 512);
                const bf16x8 v0 = (bf16x8){a0[0], a0[1], a0[2], a0[3], a1[0], a1[1], a1[2], a1[3]};
                const bf16x8 v1 = (bf16x8){c0[0], c0[1], c0[2], c0[3], c1[0], c1[1], c1[2], c1[3]};
                o0 = __builtin_amdgcn_mfma_f32_32x32x16_bf16(v0, pf[s], o0, 0, 0, 0);
                o1 = __builtin_amdgcn_mfma_f32_32x32x16_bf16(v1, pf[s], o1, 0, 0, 0);
            }
        }
        const float inv = 1.0f / l;
        bf16* op = Oout + rowq * 512 + h * 64 + 4 * hi;
#pragma unroll
        for (int g = 0; g < 4; ++g) {
            u32x2 w; w.x = pk2(o0[4*g+0] * inv, o0[4*g+1] * inv); w.y = pk2(o0[4*g+2] * inv, o0[4*g+3] * inv); *(u32x2*)(op + 8 * g) = w;
            u32x2 z; z.x = pk2(o1[4*g+0] * inv, o1[4*g+1] * inv); z.y = pk2(o1[4*g+2] * inv, o1[4*g+3] * inv); *(u32x2*)(op + 32 + 8 * g) = z;
        }
        if (C == 1 && hi == 0) LSEout[rowq * 8 + h] = mx + logf(l);
    }
    asm volatile("s_waitcnt vmcnt(0)" ::: "memory");
    __syncthreads();
#undef ATT_DMA_K
#undef ATT_DMA_V
#undef ATT_LOAD_Q
}
}
__global__ void __launch_bounds__(512, 2) hymba_fwd(Args a) {
    extern __shared__ __attribute__((aligned(16))) unsigned char lds[];
    cg::grid_group grid = cg::this_grid();
    const int tid = threadIdx.x, lane = tid & 63, wave = __builtin_amdgcn_readfirstlane(tid >> 6);
    const int G = gridDim.x, bid = blockIdx.x;
    const int gw = bid * 8 + wave, NGW = G * 8, gt = bid * 512 + tid, NGT = G * 512;
    unsigned char* ws = a.ws;
    const float* x = a.in[0]; const float* g_attn = a.in[1]; const float* w_in = a.in[2]; const float* b_in = a.in[3]; const float* sinks = a.in[4];
    const float* rel_table = a.in[5]; const float* g_out_a = a.in[6]; const float* g_out_b = a.in[7]; const float* w_o = a.in[8]; const float* g_ffn = a.in[9];
    const float* w_gate = a.in[10]; const float* w_up = a.in[11]; const float* w_down = a.in[12]; const float* g_final = a.in[13];
    float* out = a.out;
    float* ssq1 = (float*)(ws + WS_SSQ1); float* biasT = (float*)(ws + WS_BIAS); float* ropeC = (float*)(ws + WS_ROPE); float* ropeS = ropeC + SEQ * 32;
    bf16* W1t = (bf16*)(ws + WS_W1); bf16* W2t = (bf16*)(ws + WS_W2); bf16* W3t = (bf16*)(ws + WS_W3); bf16* W4t = (bf16*)(ws + WS_W4);
    bf16* XN = (bf16*)(ws + WS_XN); bf16* QKV = (bf16*)(ws + WS_QKV); bf16* OA = (bf16*)(ws + WS_OA); bf16* OB = (bf16*)(ws + WS_OB);
    float* LSE = (float*)(ws + WS_LSE); bf16* X1B = (bf16*)(ws + WS_X1B); bf16* ACT = (bf16*)(ws + WS_ACT);
    LAS unsigned char* ldsl = (LAS unsigned char*)lds;
    for (int u = tid; u < 128; u += 512) ((LAS unsigned*)(ldsl + LDSCTL_OFF))[u] = 0u;
    __syncthreads();
    XcdBarrier bar = xcd_barrier_post((unsigned*)(a.ws + WS_BAR), (volatile LAS unsigned*)(ldsl + LDSCTL_OFF + 320) + 8);

    {
        LAS float* scr = (LAS float*)(ldsl + wave * 16384);
        constexpr int I1 = 16 * 72, I2 = 16 * 32, I3 = 16 * 88, I4 = 44 * 32, NIT = I1 + I2 + 2 * I3 + I4;
        for (int it = gw; it < NIT; it += NGW) {
            int r = it;
            if (r < I1) { const int kb = r / 72, nb = r % 72; tr_item<true>(w_in, DM, NP, 64 * kb, 32 * nb, W1t, 32 * nb, scr, lane, nullptr); continue; } r -= I1;
            if (r < I2) { const int kb = r / 32, nb = r % 32; tr_item<false>(w_o, DM, DM, 64 * kb, 32 * nb, W2t, 32 * nb, scr, lane, nullptr); continue; } r -= I2;
            if (r < I3) { const int kb = r / 88, nb = r % 88, n0 = 32 * nb; tr_item<false>(w_gate, DM, FF, 64 * kb, n0, W3t, 256 * (n0 >> 7) + (n0 & 127), scr, lane, g_ffn); continue; } r -= I3;
            if (r < I3) { const int kb = r / 88, nb = r % 88, n0 = 32 * nb; tr_item<false>(w_up, DM, FF, 64 * kb, n0, W3t, 256 * (n0 >> 7) + 128 + (n0 & 127), scr, lane, g_ffn); continue; } r -= I3;
            { const int kb = r / 32, nb = r % 32; tr_item<false>(w_down, FF, DM, 64 * kb, 32 * nb, W4t, 32 * nb, scr, lane, nullptr); }
        }
        for (int m = gw; m < M; m += NGW) {
            const f32x4* xr = (const f32x4*)(x + (size_t)m * DM) + lane; f32x4 v[4]; float s = 0.f;
#pragma unroll
            for (int j = 0; j < 4; ++j) { v[j] = xr[64 * j]; s += (v[j].x * v[j].x + v[j].y * v[j].y) + (v[j].z * v[j].z + v[j].w * v[j].w); }
            const float rs = 1.0f / sqrtf(wave_sum(s) * (1.0f / DM) + EPS);
            unsigned long long* o8 = (unsigned long long*)(XN + (size_t)m * DM) + lane;
#pragma unroll
            for (int j = 0; j < 4; ++j) { const f32x4 g = ((const f32x4*)g_attn)[lane + 64 * j];
                o8[64 * j] = (unsigned long long)pk2(v[j].x * rs * g.x, v[j].y * rs * g.y) | ((unsigned long long)pk2(v[j].z * rs * g.z, v[j].w * rs * g.w) << 32); }
        }
        for (int i = gt; i < SEQ * 32; i += NGT) { const int pos = i >> 5, f = i & 31;
            const float inv_freq = (float)exp2(-(double)f * (17.194602975157967 / 32.0));
            const float ang = (float)pos * inv_freq;
            double rev = (double)ang * 0.15915494309189535; rev -= rint(rev);
            ropeC[i] = __builtin_amdgcn_cosf((float)rev); ropeS[i] = __builtin_amdgcn_sinf((float)rev); }
        for (int i = gt; i < 3 * 8 * 129; i += NGT) { const int d = i % 129, bh = i / 129, h = bh & 7, br = bh >> 3; const int dil = br == 0 ? 1 : (br == 1 ? 4 : 16);
            biasT[bh * BIAS_LD + d] = rel_table[t5_bucket(d * dil) * 8 + h]; }
        for (int i = gt; i < M; i += NGT) ssq1[i] = 0.f;
    }
    grid.sync();
    { pg8::Gemm g{XN, W1t, M, NP, DM}; pg8::StaticOrder S; S.init(M, NP, G, bid); pg8::EpiQKV E{QKV, b_in, ropeC, ropeS};
      pg8::gemm_phase<pg8::EpiQKV, pg8::StaticOrder, true, true>(ldsl, g, S, E); }
#if defined(REP_G1)
    { pg8::Gemm g{XN, W1t, M, NP, DM}; pg8::StaticOrder S; S.init(M, NP, G, bid); pg8::EpiQKV E{QKV, b_in, ropeC, ropeS};
      pg8::gemm_phase<pg8::EpiQKV, pg8::StaticOrder, true, true>(ldsl, g, S, E); }
#endif
    xcd_barrier(bar);
#ifdef NAIVE_ATTN
    naive_attn(QKV, OA, OB, LSE, sinks, biasT, gt, NGT);
#else
    for (int wg = bid; wg < 256; wg += G) {
        const int c = wg >> 6, b = (wg >> 3) & 7, h = wg & 7;
        if (c == 0) att::attn_wg<0>(QKV, OA, nullptr, b, h, 1, sinks[h], biasT, ldsl, tid, lane, wave);
        else att::attn_wg<1>(QKV, OB + (size_t)(c - 1) * M * 512, LSE + (size_t)(c - 1) * M * 8, b, h, c == 1 ? 1 : (c == 2 ? 4 : 16), 0.f, biasT + ((c - 1) * 8 + h) * BIAS_LD, ldsl, tid, lane, wave);
    }
#endif
#if defined(REP_ATT)
#ifdef NAIVE_ATTN
    naive_attn(QKV, OA, OB, LSE, sinks, biasT, gt, NGT);
#else
    for (int wg = bid; wg < 256; wg += G) {
        const int c = wg >> 6, b = (wg >> 3) & 7, h = wg & 7;
        if (c == 0) att::attn_wg<0>(QKV, OA, nullptr, b, h, 1, sinks[h], biasT, ldsl, tid, lane, wave);
        else att::attn_wg<1>(QKV, OB + (size_t)(c - 1) * M * 512, LSE + (size_t)(c - 1) * M * 8, b, h, c == 1 ? 1 : (c == 2 ? 4 : 16), 0.f, biasT + ((c - 1) * 8 + h) * BIAS_LD, ldsl, tid, lane, wave);
    }
#endif
#endif
    xcd_barrier(bar);
    for (int m = gw; m < M; m += NGW) {
        float v[16];
        if (lane < 32) { const v4u* p = (const v4u*)(OA + (size_t)m * 512 + lane * 16);
#pragma unroll
            for (int j = 0; j < 2; ++j) { const v4u w = p[j]; v[8*j+0] = bflo(w.x); v[8*j+1] = bfhi(w.x); v[8*j+2] = bflo(w.y); v[8*j+3] = bfhi(w.y); v[8*j+4] = bflo(w.z); v[8*j+5] = bfhi(w.z); v[8*j+6] = bflo(w.w); v[8*j+7] = bfhi(w.w); }
        } else { const int cb = (lane - 32) * 16, h = cb >> 6;
            const float l1 = LSE[(size_t)m * 8 + h], l2 = LSE[(size_t)M * 8 + (size_t)m * 8 + h], l3 = LSE[(size_t)2 * M * 8 + (size_t)m * 8 + h];
            const float mxl = fmaxf(l1, fmaxf(l2, l3)); float w1 = __expf(l1 - mxl), w2 = __expf(l2 - mxl), w3 = __expf(l3 - mxl); const float wi = 1.0f / (w1 + w2 + w3); w1 *= wi; w2 *= wi; w3 *= wi;
#pragma unroll
            for (int j = 0; j < 16; ++j) v[j] = 0.f;
#pragma unroll
            for (int br = 0; br < 3; ++br) { const float wb = br == 0 ? w1 : (br == 1 ? w2 : w3); const v4u* p = (const v4u*)(OB + (size_t)br * M * 512 + (size_t)m * 512 + cb);
#pragma unroll
                for (int j = 0; j < 2; ++j) { const v4u w = p[j]; v[8*j+0] += wb * bflo(w.x); v[8*j+1] += wb * bfhi(w.x); v[8*j+2] += wb * bflo(w.y); v[8*j+3] += wb * bfhi(w.y); v[8*j+4] += wb * bflo(w.z); v[8*j+5] += wb * bfhi(w.z); v[8*j+6] += wb * bflo(w.w); v[8*j+7] += wb * bfhi(w.w); } }
        }
        float ss = 0.f;
#pragma unroll
        for (int j = 0; j < 16; ++j) ss += v[j] * v[j];
#pragma unroll
        for (int o = 1; o < 32; o <<= 1) ss += __shfl_xor(ss, o);
        const float rs = 1.0f / sqrtf(ss * (1.0f / 512.0f) + EPS);
        const float* gp = (lane < 32) ? (g_out_a + lane * 16) : (g_out_b + (lane - 32) * 16);
        v4u w0, w1v;
        w0.x = pk2(v[0] * rs * gp[0], v[1] * rs * gp[1]); w0.y = pk2(v[2] * rs * gp[2], v[3] * rs * gp[3]); w0.z = pk2(v[4] * rs * gp[4], v[5] * rs * gp[5]); w0.w = pk2(v[6] * rs * gp[6], v[7] * rs * gp[7]);
        w1v.x = pk2(v[8] * rs * gp[8], v[9] * rs * gp[9]); w1v.y = pk2(v[10] * rs * gp[10], v[11] * rs * gp[11]); w1v.z = pk2(v[12] * rs * gp[12], v[13] * rs * gp[13]); w1v.w = pk2(v[14] * rs * gp[14], v[15] * rs * gp[15]);
        v4u* op = (v4u*)(XN + (size_t)m * DM + lane * 16); op[0] = w0; op[1] = w1v;
    }
    xcd_barrier(bar);
    { pg8::Gemm g{XN, W2t, M, DM, DM}; pg8::StaticOrder S; S.init(M, DM, G, bid); pg8::EpiRes1 E{x, out, X1B, ssq1};
      pg8::gemm_phase<pg8::EpiRes1, pg8::StaticOrder, true, true>(ldsl, g, S, E); }
    xcd_barrier(bar);
    { pg8::Gemm g{X1B, W3t, M, NGU, DM}; pg8::StaticOrder S; S.init(M, NGU, G, bid); pg8::EpiSwiGLU E{ACT, ssq1};
      pg8::gemm_phase<pg8::EpiSwiGLU, pg8::StaticOrder, true, true>(ldsl, g, S, E); }
#if defined(REP_G3)
    { pg8::Gemm g{X1B, W3t, M, NGU, DM}; pg8::StaticOrder S; S.init(M, NGU, G, bid); pg8::EpiSwiGLU E{ACT, ssq1};
      pg8::gemm_phase<pg8::EpiSwiGLU, pg8::StaticOrder, true, true>(ldsl, g, S, E); }
#endif
    xcd_barrier(bar);
    { pg8::Gemm g{ACT, W4t, M, DM, FF}; pg8::StaticOrder S; S.init(M, DM, G, bid); pg8::EpiRes2 E{out};
      pg8::gemm_phase<pg8::EpiRes2, pg8::StaticOrder, true, true>(ldsl, g, S, E); }
    xcd_barrier(bar);
    for (int m = gw; m < M; m += NGW) {
        f32x4* xr = (f32x4*)(out + (size_t)m * DM) + lane; f32x4 v[4]; float s = 0.f;
#pragma unroll
        for (int j = 0; j < 4; ++j) { v[j] = xr[64 * j]; s += (v[j].x * v[j].x + v[j].y * v[j].y) + (v[j].z * v[j].z + v[j].w * v[j].w); }
        const float rs = 1.0f / sqrtf(wave_sum(s) * (1.0f / DM) + EPS);
#pragma unroll
        for (int j = 0; j < 4; ++j) { const f32x4 g = ((const f32x4*)g_final)[lane + 64 * j]; xr[64 * j] = v[j] * rs * g; }
    }
}

extern "C" void kernel_launch(void* const* d_in, const int* in_sizes, int n_in, void* d_out, int out_size, void* d_ws, size_t ws_size, hipStream_t stream) {
    static int grid = 0;
    if (grid == 0) {
        if (n_in != 14 || out_size != M * DM || ws_size < WS_END) { fprintf(stderr, "kernel_launch: unexpected shapes (n_in %d out %d ws %zu)\n", n_in, out_size, ws_size); grid = -1; return; }
        int dev = 0, cus = 0, per_cu = 0;
        hipGetDevice(&dev); hipDeviceGetAttribute(&cus, hipDeviceAttributeMultiprocessorCount, dev);
        hipFuncSetAttribute((const void*)hymba_fwd, hipFuncAttributeMaxDynamicSharedMemorySize, LDS_BYTES);
        hipOccupancyMaxActiveBlocksPerMultiprocessor(&per_cu, (const void*)hymba_fwd, 512, LDS_BYTES);
        if (per_cu < 1) { fprintf(stderr, "kernel_launch: occupancy query says %d blocks per CU\n", per_cu); per_cu = 1; }
        (void)hipGetLastError();
        grid = cus * 1;
    }
    if (grid < 0) return;
    if (hipMemsetAsync((char*)d_ws + WS_BAR, 0, 16384, stream) != hipSuccess) { fprintf(stderr, "kernel_launch: memset failed\n"); return; }
    Args a{};
    for (int i = 0; i < 14; ++i) a.in[i] = (const float*)d_in[i];
    a.out = (float*)d_out; a.ws = (unsigned char*)d_ws;
    void* args[] = {&a};
    hipError_t e = hipLaunchCooperativeKernel((const void*)hymba_fwd, dim3(grid), dim3(512), args, LDS_BYTES, stream);
    if (e != hipSuccess) fprintf(stderr, "cooperative launch failed: %s (grid %d)\n", hipGetErrorString(e), grid);
}
```

```cpp
#include <hip/hip_runtime.h>
#include <hip/hip_cooperative_groups.h>
#include <cstdio>
#include <cstdint>
namespace cg = cooperative_groups;
namespace pg8 {
#define PG8_LAS __attribute__((address_space(3)))
typedef unsigned short bf16_t;
typedef short bf16x8 __attribute__((ext_vector_type(8)));
typedef float f32x4 __attribute__((ext_vector_type(4)));
typedef unsigned u32x4 __attribute__((ext_vector_type(4)));
constexpr int BM = 256, BK = 64, HALF = 128, HTB = HALF * BK * 2  , STAGE_BYTES = 8 * HTB, NXCD = 8, WGM = 8;

__host__ __device__ __forceinline__ int lds_byte(int r, int c) { const int st = (r >> 4) * 2 + (c >> 5), rr = r & 15, cc = c & 31, ob = rr * 64 + cc * 2; return st * 1024 + (ob ^ (((ob >> 9) & 1) << 5)); }
__host__ __device__ __forceinline__ void stage_rc(int b, int& R, int& C) { const int st = b / 1024, sb = b % 1024, swz = sb ^ (((sb >> 9) & 1) << 5); R = (st >> 1) * 16 + swz / 64; C = (st & 1) * 32 + (swz % 64) / 2; }
__host__ __device__ __forceinline__ int perm32(int rho) { const int n = rho >> 4, i = rho & 15; return 8 * (i >> 2) + 4 * n + (i & 3); }

struct Unit { int pm, pn; };
struct Gemm { const bf16_t* A; const bf16_t* Bt; int M, N, K; };

struct StaticOrder {
    int nM, nN, nwg, G, c;
    __host__ __device__ void init(int M, int N, int G_, int c_) { nM = M / BM; nN = N / BM; nwg = nM * nN; G = G_; c = c_; }
    __host__ __device__ bool next(int i, Unit& u) const {
        const long L = (long)i * G + c; if (L >= nwg) return false;
        int wgid = (int)L; { const int q = nwg / NXCD, r = nwg % NXCD, xcd = wgid % NXCD, off = wgid / NXCD; wgid = (xcd < r ? xcd * (q + 1) : r * (q + 1) + (xcd - r) * q) + off; }
        const int nig = WGM * nN, gid = wgid / nig, fm = gid * WGM, gsz = (nM - fm) < WGM ? (nM - fm) : WGM;
        u.pm = fm + ((wgid % nig) % gsz); u.pn = (wgid % nig) / gsz; return true;
    }
    __device__ __forceinline__ void a_ready(const Unit&) const {}
    __device__ __forceinline__ void done(const Unit&) const {}
};

__device__ __forceinline__ unsigned cvt_pk_bf16(float lo, float hi) { unsigned r; asm volatile("v_cvt_pk_bf16_f32 %0, %1, %2" : "=v"(r) : "v"(lo), "v"(hi)); return r; }
typedef float f32x2 __attribute__((ext_vector_type(2)));
template <class Epi, class Sched, bool ALIGN_EPI = false, bool SP2 = false>
__device__ __forceinline__ void gemm_phase(PG8_LAS unsigned char* lds, const Gemm g, const Sched& S, const Epi& E) {
    const int tid = threadIdx.x, wid = __builtin_amdgcn_readfirstlane(tid >> 6), lane = tid & 63, wr = wid >> 2, wc = wid & 3, fr = lane & 15, fq = lane >> 4;
    const int K = g.K, nt = K / BK;
    unsigned voffA[2], voffB[2];
#pragma unroll
    for (int i = 0; i < 2; ++i) { int R, C; stage_rc(tid * 16 + i * 8192, R, C); const int Rb = Epi::PERM ? ((R & ~31) + perm32(R & 31)) : R;
        voffA[i] = (unsigned)(R * K + C) * 2u; voffB[i] = (unsigned)(Rb * K + C) * 2u; }
    const size_t kstep = (size_t)(BK * 2);
    const size_t hstep = (size_t)HALF * K * 2;
    const size_t tstep = 2 * hstep;
    const unsigned ldsw = (unsigned)wid * 1024u;
    const int aoff = lds_byte(wr * 64 + fr, fq * 8), boff = lds_byte(wc * 32 + fr, fq * 8);
#define PG8_SA(b, h) (((b) * 2 + (h)) * HTB)
#define PG8_SB(b, h) ((4 + (b) * 2 + (h)) * HTB)
#define PG8_STAGE(bufoff, gbase, voff) do { _Pragma("unroll") for (int _i = 0; _i < 2; ++_i) \
        __builtin_amdgcn_global_load_lds((const unsigned*)((const char*)(gbase) + (voff)[_i]), (PG8_LAS unsigned*)(lds + (bufoff) + ldsw + _i * 8192), 16, 0, 0); } while (0)
#define PG8_LDA(dst, b, h) do { _Pragma("unroll") for (int m = 0; m < 4; ++m) _Pragma("unroll") for (int k = 0; k < 2; ++k) dst[m][k] = *(const PG8_LAS bf16x8*)(lds + PG8_SA(b, h) + aoff + m * 2048 + k * 1024); } while (0)
#define PG8_LDB(dst, b, h) do { _Pragma("unroll") for (int n = 0; n < 2; ++n) _Pragma("unroll") for (int k = 0; k < 2; ++k) dst[n][k] = *(const PG8_LAS bf16x8*)(lds + PG8_SB(b, h) + boff + n * 2048 + k * 1024); } while (0)
#define PG8_MMA(ai, bj, At, Bt) do { __builtin_amdgcn_s_setprio(1); _Pragma("unroll") for (int m = 0; m < 4; ++m) _Pragma("unroll") for (int n = 0; n < 2; ++n) _Pragma("unroll") for (int k = 0; k < 2; ++k) \
        acc[ai][bj][m][n] = __builtin_amdgcn_mfma_f32_16x16x32_bf16(Bt[n][k], At[m][k], acc[ai][bj][m][n], 0, 0, 0); __builtin_amdgcn_s_setprio(0); } while (0)
#define PG8_WAIT_V(n) asm volatile("s_waitcnt vmcnt(" #n ")" ::: "memory")
#define PG8_WAIT_L(n) asm volatile("s_waitcnt lgkmcnt(" #n ")" ::: "memory")
#define PG8_BAR __builtin_amdgcn_s_barrier()
#define PG8_SCHED __builtin_amdgcn_sched_barrier(0)
    Unit cur, nxt; int ui = 0;
    if (!S.next(0, cur)) return;
    f32x4 acc[2][2][4][2];
#pragma unroll
    for (int a = 0; a < 2; ++a)
#pragma unroll
        for (int b = 0; b < 2; ++b)
#pragma unroll
            for (int m = 0; m < 4; ++m)
#pragma unroll
                for (int n = 0; n < 2; ++n) acc[a][b][m][n] = (f32x4){0.f, 0.f, 0.f, 0.f};
    bf16x8 At[4][2], B0[2][2], B1[2][2];
    const char* cA = (const char*)g.A + (size_t)cur.pm * tstep; const char* cB = (const char*)g.Bt + (size_t)cur.pn * tstep;
    S.a_ready(cur);
    if constexpr (SP2) {
        PG8_STAGE(PG8_SB(0, 0), cB, voffB); PG8_STAGE(PG8_SB(0, 1), cB + hstep, voffB); PG8_STAGE(PG8_SA(0, 0), cA, voffA); PG8_STAGE(PG8_SA(0, 1), cA + hstep, voffA);
        if (wr == 1) PG8_BAR;
        PG8_WAIT_V(2); PG8_BAR;
        PG8_STAGE(PG8_SB(1, 0), cB + kstep, voffB); PG8_STAGE(PG8_SA(1, 0), cA + kstep, voffA); PG8_STAGE(PG8_SB(1, 1), cB + hstep + kstep, voffB);
        PG8_WAIT_V(6); PG8_BAR;
    } else {
        PG8_STAGE(PG8_SB(0, 0), cB, voffB); PG8_STAGE(PG8_SA(0, 0), cA, voffA); PG8_STAGE(PG8_SB(0, 1), cB + hstep, voffB); PG8_STAGE(PG8_SA(0, 1), cA + hstep, voffA);
        if (wr == 1) PG8_BAR;
        PG8_WAIT_V(4); PG8_BAR;
        PG8_STAGE(PG8_SB(1, 0), cB + kstep, voffB); PG8_STAGE(PG8_SA(1, 0), cA + kstep, voffA); PG8_STAGE(PG8_SB(1, 1), cB + hstep + kstep, voffB);
        PG8_WAIT_V(6); PG8_BAR;
    }
    for (;;) {
        const bool has_next = S.next(ui + 1, nxt);
        const char* nA = has_next ? (const char*)g.A + (size_t)nxt.pm * tstep : cA; const char* nB = has_next ? (const char*)g.Bt + (size_t)nxt.pn * tstep : cB;
        for (int t = 0; t < nt; t += 2) {
            const bool last = (t == nt - 2);
            const char* a1 = cA + (size_t)(t + 1) * kstep;
            const char* a2 = last ? nA : cA + (size_t)(t + 2) * kstep; const char* b2 = last ? nB : cB + (size_t)(t + 2) * kstep;
            const char* a3 = a2 + kstep; const char* b3 = b2 + kstep;
            if (last && has_next) S.a_ready(nxt);
            if constexpr (SP2) {
            PG8_LDB(B0, 0, 0); PG8_LDB(B1, 0, 1); PG8_SCHED; PG8_LDA(At, 0, 0); PG8_STAGE(PG8_SA(1, 1), a1 + hstep, voffA);
            PG8_WAIT_V(8); PG8_WAIT_L(0); PG8_BAR; PG8_MMA(0, 0, At, B0); PG8_MMA(0, 1, At, B1); PG8_BAR; PG8_SCHED;
            PG8_LDA(At, 0, 1); PG8_STAGE(PG8_SB(0, 0), b2, voffB); PG8_STAGE(PG8_SB(0, 1), b2 + hstep, voffB); PG8_STAGE(PG8_SA(0, 0), a2, voffA);
            PG8_WAIT_V(8); PG8_WAIT_L(0); PG8_BAR; PG8_MMA(1, 0, At, B0); PG8_MMA(1, 1, At, B1); PG8_BAR; PG8_SCHED;
            PG8_LDB(B0, 1, 0); PG8_LDB(B1, 1, 1); PG8_SCHED; PG8_LDA(At, 1, 0); PG8_STAGE(PG8_SA(0, 1), a2 + hstep, voffA);
            PG8_WAIT_V(8); PG8_WAIT_L(0); PG8_BAR; PG8_MMA(0, 0, At, B0); PG8_MMA(0, 1, At, B1); PG8_BAR; PG8_SCHED;
            PG8_LDA(At, 1, 1); PG8_STAGE(PG8_SB(1, 0), b3, voffB); PG8_STAGE(PG8_SB(1, 1), b3 + hstep, voffB); PG8_STAGE(PG8_SA(1, 0), a3, voffA);
            PG8_WAIT_V(8); PG8_WAIT_L(0); PG8_BAR; PG8_MMA(1, 0, At, B0); PG8_MMA(1, 1, At, B1); PG8_BAR; PG8_SCHED;
            } else {
            PG8_LDB(B0, 0, 0); PG8_SCHED; PG8_LDA(At, 0, 0); PG8_STAGE(PG8_SA(1, 1), a1 + hstep, voffA);
            PG8_WAIT_L(8); PG8_BAR; PG8_WAIT_L(0); PG8_MMA(0, 0, At, B0); PG8_BAR; PG8_SCHED;
            PG8_LDB(B1, 0, 1); PG8_STAGE(PG8_SB(0, 0), b2, voffB);
            PG8_BAR; PG8_WAIT_L(0); PG8_MMA(0, 1, At, B1); PG8_BAR;
            PG8_LDA(At, 0, 1); PG8_STAGE(PG8_SA(0, 0), a2, voffA);
            PG8_BAR; PG8_WAIT_L(0); PG8_MMA(1, 0, At, B0); PG8_BAR; PG8_SCHED;
            PG8_STAGE(PG8_SB(0, 1), b2 + hstep, voffB);
            PG8_WAIT_V(6); PG8_BAR; PG8_MMA(1, 1, At, B1); PG8_BAR;
            PG8_LDB(B0, 1, 0); PG8_SCHED; PG8_LDA(At, 1, 0); PG8_STAGE(PG8_SA(0, 1), a2 + hstep, voffA);
            PG8_WAIT_L(8); PG8_BAR; PG8_WAIT_L(0); PG8_MMA(0, 0, At, B0); PG8_BAR; PG8_SCHED;
            PG8_LDB(B1, 1, 1); PG8_STAGE(PG8_SB(1, 0), b3, voffB);
            PG8_BAR; PG8_WAIT_L(0); PG8_MMA(0, 1, At, B1); PG8_BAR;
            PG8_LDA(At, 1, 1); PG8_STAGE(PG8_SA(1, 0), a3, voffA);
            PG8_BAR; PG8_WAIT_L(0); PG8_MMA(1, 0, At, B0); PG8_BAR; PG8_SCHED;
            PG8_STAGE(PG8_SB(1, 1), b3 + hstep, voffB);
            PG8_WAIT_V(6); PG8_BAR; PG8_MMA(1, 1, At, B1); PG8_BAR;
            }
        }
        if constexpr (ALIGN_EPI) { if (wr == 0) PG8_BAR; }
        if constexpr (!Epi::AFTER_DRAIN) { E(acc, cur, wr, wc, fr, fq); S.done(cur); }
        if (!has_next) break;
#pragma unroll
        for (int a = 0; a < 2; ++a)
#pragma unroll
            for (int b = 0; b < 2; ++b)
#pragma unroll
                for (int m = 0; m < 4; ++m)
#pragma unroll
                    for (int n = 0; n < 2; ++n) acc[a][b][m][n] = (f32x4){0.f, 0.f, 0.f, 0.f};
        cur = nxt; cA = nA; cB = nB; ++ui;
        if constexpr (ALIGN_EPI) { if (wr == 1) PG8_BAR; }
    }
    PG8_WAIT_V(0);
    if constexpr (!ALIGN_EPI) { if (wr == 0) PG8_BAR; }
    PG8_BAR;
    if constexpr (Epi::AFTER_DRAIN) { E.fused(acc, cur, wr, wc, fr, fq, lds, wid, lane); S.done(cur); }
#undef PG8_SA
#undef PG8_SB
#undef PG8_STAGE
#undef PG8_LDA
#undef PG8_LDB
#undef PG8_MMA
#undef PG8_WAIT_V
#undef PG8_WAIT_L
#undef PG8_BAR
#undef PG8_SCHED
}
}
namespace pg8 {
typedef unsigned u32x2 __attribute__((ext_vector_type(2)));
constexpr int LD_QKV = 2304, LD_D = 1024, LD_FF = 2816;
constexpr float RMS_EPS = 1e-5f;

struct EpiQKV {
    static constexpr bool PERM = true, AFTER_DRAIN = false;
    bf16_t* O; const float* bias; const float* ropeC; const float* ropeS;
    __device__ __forceinline__ void operator()(const f32x4 (&acc)[2][2][4][2], const Unit& u, int wr, int wc, int fr, int fq) const {
        const int row0 = u.pm * BM + wr * 64 + fr;
        const float sc = (u.pn < 2 || u.pn == 3 || u.pn == 4) ? 0.125f : 1.0f;
#pragma unroll
        for (int bj = 0; bj < 2; ++bj) {
            const bool rope = (u.pn < 2) || (u.pn == 2 && bj == 0);
            if (rope) {
                const int dl = 16 * (wc & 1) + 4 * fq, colh = u.pn * BM + bj * HALF + 64 * (wc >> 1);
                const f32x4 b0 = *(const f32x4*)(bias + colh + dl), b1 = *(const f32x4*)(bias + colh + 32 + dl);
#pragma unroll
                for (int ai = 0; ai < 2; ++ai)
#pragma unroll
                    for (int m = 0; m < 4; ++m) { const int r = row0 + ai * HALF + m * 16, pos = r & 8191;
                        const f32x4 cs = *(const f32x4*)(ropeC + pos * 32 + dl), sn = *(const f32x4*)(ropeS + pos * 32 + dl);
                        const f32x4 t1 = acc[ai][bj][m][0] + b0, t2 = acc[ai][bj][m][1] + b1;
                        const f32x4 o1 = (t1 * cs - t2 * sn) * sc, o2 = (t1 * sn + t2 * cs) * sc;
                        bf16_t* p = O + (size_t)r * LD_QKV + colh + dl;
                        u32x2 w1; w1.x = cvt_pk_bf16(o1[0], o1[1]); w1.y = cvt_pk_bf16(o1[2], o1[3]); *(u32x2*)p = w1;
                        u32x2 w2; w2.x = cvt_pk_bf16(o2[0], o2[1]); w2.y = cvt_pk_bf16(o2[2], o2[3]); *(u32x2*)(p + 32) = w2; }
            } else {
                const int col0 = u.pn * BM + bj * HALF + wc * 32 + 8 * fq;
                const f32x4 b0 = *(const f32x4*)(bias + col0), b1 = *(const f32x4*)(bias + col0 + 4);
#pragma unroll
                for (int ai = 0; ai < 2; ++ai)
#pragma unroll
                    for (int m = 0; m < 4; ++m) { const f32x4 v0 = (acc[ai][bj][m][0] + b0) * sc, v1 = (acc[ai][bj][m][1] + b1) * sc;
                        u32x4 w; w.x = cvt_pk_bf16(v0[0], v0[1]); w.y = cvt_pk_bf16(v0[2], v0[3]); w.z = cvt_pk_bf16(v1[0], v1[1]); w.w = cvt_pk_bf16(v1[2], v1[3]);
                        *(u32x4*)(O + (size_t)(row0 + ai * HALF + m * 16) * LD_QKV + col0) = w; }
            }
        }
    }
};
struct EpiRes1 {
    static constexpr bool PERM = false, AFTER_DRAIN = false;
    const float* X; float* X1; bf16_t* X1B; float* ssq;
    __device__ __forceinline__ void operator()(const f32x4 (&acc)[2][2][4][2], const Unit& u, int wr, int wc, int fr, int fq) const {
        const int row0 = u.pm * BM + wr * 64 + fr, col0 = u.pn * BM + wc * 32 + 4 * fq;
#pragma unroll
        for (int ai = 0; ai < 2; ++ai)
#pragma unroll
            for (int m = 0; m < 4; ++m) { const int r = row0 + ai * HALF + m * 16; const size_t off = (size_t)r * LD_D + col0; float ss = 0.f;
#pragma unroll
                for (int bj = 0; bj < 2; ++bj)
#pragma unroll
                    for (int n = 0; n < 2; ++n) { const f32x4 xv = *(const f32x4*)(X + off + bj * HALF + n * 16); const f32x4 o = xv + acc[ai][bj][m][n];
                        *(f32x4*)(X1 + off + bj * HALF + n * 16) = o; u32x2 w; w.x = cvt_pk_bf16(o[0], o[1]); w.y = cvt_pk_bf16(o[2], o[3]);
                        *(u32x2*)(X1B + off + bj * HALF + n * 16) = w; ss += (o[0] * o[0] + o[1] * o[1]) + (o[2] * o[2] + o[3] * o[3]); }
                ss += __shfl_xor(ss, 16); ss += __shfl_xor(ss, 32);
                if (fq == 0) atomicAdd(ssq + r, ss);
                if (m & 1) asm volatile("" ::: "memory"); }
    }
};
struct EpiSwiGLU {
    static constexpr bool PERM = true, AFTER_DRAIN = false;
    bf16_t* ACT; const float* ssq;
    __device__ __forceinline__ void operator()(const f32x4 (&acc)[2][2][4][2], const Unit& u, int wr, int wc, int fr, int fq) const {
        const int row0 = u.pm * BM + wr * 64 + fr, col0 = u.pn * HALF + wc * 32 + 8 * fq;
#pragma unroll
        for (int ai = 0; ai < 2; ++ai)
#pragma unroll
            for (int m = 0; m < 4; ++m) { const int r = row0 + ai * HALF + m * 16;
                const float rs = 1.0f / sqrtf(ssq[r] * (1.0f / 1024.0f) + RMS_EPS);
                float a[8];
#pragma unroll
                for (int n = 0; n < 2; ++n)
#pragma unroll
                    for (int e = 0; e < 4; ++e) { const float g = acc[ai][0][m][n][e] * rs, up = acc[ai][1][m][n][e] * rs;
                        const float sg = g * __builtin_amdgcn_rcpf(1.0f + __builtin_amdgcn_exp2f(-1.4426950408889634f * g)); a[n * 4 + e] = sg * up; }
                u32x4 w; w.x = cvt_pk_bf16(a[0], a[1]); w.y = cvt_pk_bf16(a[2], a[3]); w.z = cvt_pk_bf16(a[4], a[5]); w.w = cvt_pk_bf16(a[6], a[7]);
                *(u32x4*)(ACT + (size_t)r * LD_FF + col0) = w; }
    }
};
struct EpiRes2 {
    static constexpr bool PERM = false, AFTER_DRAIN = false;
    float* X1;
    __device__ __forceinline__ void operator()(const f32x4 (&acc)[2][2][4][2], const Unit& u, int wr, int wc, int fr, int fq) const {
        const int row0 = u.pm * BM + wr * 64 + fr, col0 = u.pn * BM + wc * 32 + 4 * fq;
#pragma unroll
        for (int ai = 0; ai < 2; ++ai)
#pragma unroll
            for (int m = 0; m < 4; ++m) { const size_t off = (size_t)(row0 + ai * HALF + m * 16) * LD_D + col0;
#pragma unroll
                for (int bj = 0; bj < 2; ++bj)
#pragma unroll
                    for (int n = 0; n < 2; ++n) { float* p = X1 + off + bj * HALF + n * 16; const f32x4 xv = *(const f32x4*)p; *(f32x4*)p = xv + acc[ai][bj][m][n]; }
                if (m & 1) asm volatile("" ::: "memory"); }
    }
};
}
#define GAS __attribute__((address_space(1)))
#define LAS __attribute__((address_space(3)))
typedef unsigned short bf16;
typedef unsigned v4u __attribute__((ext_vector_type(4)));
typedef float f32x4 __attribute__((ext_vector_type(4)));
constexpr int BATCH = 8, SEQ = 8192, DM = 1024, M = BATCH * SEQ, NP = 2304, FF = 2816, NGU = 2 * FF;
constexpr float EPS = 1e-5f;
constexpr size_t MiB = 1u << 20;
constexpr size_t WS_SSQ1 = 0, WS_BIAS = 512 * 1024, WS_ROPE = 1 * MiB;
constexpr size_t WS_W1 = 4 * MiB, WS_W2 = 9 * MiB, WS_W3 = 11 * MiB, WS_W4 = 22 * MiB;
constexpr size_t WS_XN = 32 * MiB;
constexpr size_t WS_QKV = 160 * MiB;
constexpr size_t WS_OA = 448 * MiB, WS_OB = 512 * MiB;
constexpr size_t WS_LSE = 704 * MiB;
constexpr size_t WS_X1B = 160 * MiB;
constexpr size_t WS_ACT = 288 * MiB;
constexpr size_t WS_END = 712 * MiB;
constexpr int BIAS_LD = 132;
constexpr int LDS_BYTES = 147456, LDSCTL_OFF = 131072;
constexpr size_t WS_BAR = 256 * 1024;

__device__ __forceinline__ unsigned pk2(float lo, float hi) { return pg8::cvt_pk_bf16(lo, hi); }
__device__ __forceinline__ float bflo(unsigned w) { return __uint_as_float(w << 16); }
__device__ __forceinline__ float bfhi(unsigned w) { return __uint_as_float(w & 0xffff0000u); }
__device__ __forceinline__ float wave_sum(float v) {
#pragma unroll
    for (int o = 1; o < 64; o <<= 1) v += __shfl_xor(v, o);
    return v;
}
__device__ __forceinline__ int w1_src_col(int c) {
    if (c >= 640) return c;
    const int idx = c & 127, wc = idx >> 5, w = idx & 31, fq = w >> 3, n = (w >> 2) & 1, e = w & 3;
    return (c & ~127) + 64 * (wc >> 1) + 16 * (wc & 1) + 4 * fq + e + 32 * n;
}
template <bool MAP1>
__device__ __forceinline__ void tr_item(const float* W, int K, int N, int k0, int n0, bf16* WT, int r0, LAS float* scr, int lane, const float* gk) {
    const int scol = MAP1 ? w1_src_col(r0 + (lane & 31)) : n0 + (lane & 31);
#pragma unroll 8
    for (int i = 0; i < 32; ++i) { const int kk = 2 * i + (lane >> 5); float v = W[(size_t)(k0 + kk) * N + scol]; if (gk) v *= gk[k0 + kk]; scr[kk * 33 + (lane & 31)] = v; }
    asm volatile("s_waitcnt lgkmcnt(0)" ::: "memory");
    const int c = lane & 7;
#pragma unroll
    for (int j = 0; j < 4; ++j) { const int n = (lane >> 3) + 8 * j; const LAS float* s = scr + (8 * c) * 33 + n;
        v4u o; o.x = pk2(s[0 * 33], s[1 * 33]); o.y = pk2(s[2 * 33], s[3 * 33]); o.z = pk2(s[4 * 33], s[5 * 33]); o.w = pk2(s[6 * 33], s[7 * 33]);
        *(v4u*)(WT + (size_t)(r0 + n) * K + k0 + 8 * c) = o; }
    asm volatile("s_waitcnt lgkmcnt(0)" ::: "memory");
}
__device__ __forceinline__ int t5_bucket(int dist) {
    if (dist < 16) return dist;
    const float df = (float)dist;
    int large = 16 + (int)((logf(df / 16.0f) / 4.852030263919617f) * 16.0f);
    return large < 31 ? large : 31;
}

#define XB_TMO      128
#define XB_XCNT(j)  (256  + 64 * (j))
#define XB_XSUB(j)  (1280 + 64 * (j))
#define XB_XGEN(j)  (2304 + 64 * (j))
#define XB_TOP      3328
#define XB_TOPGEN   3392
#define XCD_BAR_WORDS 3456
#define XB_SPIN_CAP (1u << 18)

__device__ __forceinline__ unsigned xb_ld(unsigned* p)              { return __hip_atomic_load(p, __ATOMIC_RELAXED, __HIP_MEMORY_SCOPE_AGENT); }
__device__ __forceinline__ unsigned xb_add(unsigned* p, unsigned v) { return __hip_atomic_fetch_add(p, v, __ATOMIC_RELAXED, __HIP_MEMORY_SCOPE_AGENT); }
__device__ __forceinline__ unsigned xb_xcc_id() { return (unsigned)__builtin_amdgcn_s_getreg((3 << 11) | 20) & 0xFu; }
#define XB_SPIN(cond, bar) do { unsigned _sp = 0; while (cond) { __builtin_amdgcn_s_sleep(1); \
    if ((++_sp & 255u) == 0u) { if (xb_ld(&(bar)[XB_TMO])) break; if (_sp > XB_SPIN_CAP) { atomicAdd(&(bar)[XB_TMO], 1u); break; } } } } while (0)

struct XcdBarrier {
    unsigned* bar; unsigned x;
    volatile LAS unsigned* st;
};

__device__ __forceinline__ XcdBarrier xcd_barrier_post(unsigned* bar, volatile LAS unsigned* st) {
    XcdBarrier b; b.bar = bar; b.x = xb_xcc_id(); b.st = st;
    if (threadIdx.x == 0) (void)xb_add(&bar[XB_XCNT(b.x)], 1u);
    return b;
}
__device__ __forceinline__ void xcd_barrier_complete(unsigned* bar, unsigned x, unsigned& nloc, unsigned& nx) {
    const unsigned G = gridDim.x * gridDim.y * gridDim.z;
    unsigned sum, cnt, mine, sp = 0u;
    for (;;) {
        sum = 0u; cnt = 0u; mine = 0u;
#pragma unroll
        for (unsigned j = 0; j < 16; ++j) { const unsigned c = xb_ld(&bar[XB_XCNT(j)]); sum += c; cnt += (c > 0u) ? 1u : 0u; mine = (j == x) ? c : mine; }
        if (sum == G) break;
        __builtin_amdgcn_s_sleep(1);
        if ((++sp & 255u) == 0u) { if (xb_ld(&bar[XB_TMO])) break; if (sp > XB_SPIN_CAP) { atomicAdd(&bar[XB_TMO], 1u); break; } }
    }
    nloc = mine > 0u ? mine : 1u; nx = cnt > 0u ? cnt : 1u;
}

__device__ __forceinline__ void xcd_barrier(const XcdBarrier& b) {
    asm volatile("s_waitcnt vmcnt(0)" ::: "memory");
    __syncthreads();
    if (threadIdx.x == 0) {
        unsigned* bar = b.bar;
        __builtin_amdgcn_s_waitcnt(0);
        unsigned nloc = b.st[0], nx = b.st[1];
        if (nloc == 0u) { xcd_barrier_complete(bar, b.x, nloc, nx); b.st[0] = nloc; b.st[1] = nx; }
        const unsigned old = xb_add(&bar[XB_XSUB(b.x)], 1u);
        const unsigned gen = old / nloc;
        if (old + 1u == (gen + 1u) * nloc) {
            __builtin_amdgcn_fence(__ATOMIC_RELEASE, "agent");
            asm volatile("s_waitcnt vmcnt(0)" ::: "memory");
            const unsigned og = xb_add(&bar[XB_TOP], 1u);
            const unsigned tg = og / nx;
            if (og + 1u == (tg + 1u) * nx) xb_add(&bar[XB_TOPGEN], 1u);
            else XB_SPIN(xb_ld(&bar[XB_TOPGEN]) == tg, bar);
            __builtin_amdgcn_fence(__ATOMIC_ACQUIRE, "agent");
            xb_add(&bar[XB_XGEN(b.x)], 1u);
            asm volatile("s_waitcnt vmcnt(0)" ::: "memory");
        } else {
            XB_SPIN(xb_ld(&bar[XB_XGEN(b.x)]) == gen, bar);
            __builtin_amdgcn_fence(__ATOMIC_ACQUIRE, "agent");
            asm volatile("s_waitcnt vmcnt(0)" ::: "memory");
        }
    }
    __syncthreads();
}

struct Args { const float* in[14]; float* out; unsigned char* ws; };

__device__ __forceinline__ void naive_attn(const bf16* QKV, bf16* OA, bf16* OB, float* LSE, const float* sinks, const float* biasT, int gt, int NGT) {
    for (int it = gt; it < 4 * 8 * M; it += NGT) {
        const int m = it & (M - 1), ch = it >> 16, c = ch >> 3, h = ch & 7, pos = m & (SEQ - 1);
        int qcol, kcol, vcol, dil, nb;
        if (c == 0) { qcol = h * 64; kcol = 512 + (h >> 2) * 64; vcol = 640 + (h >> 2) * 64; dil = 1; nb = 127; }
        else { qcol = 768 + h * 64; kcol = 1280 + h * 64; vcol = 1792 + h * 64; dil = (c == 1) ? 1 : (c == 2 ? 4 : 16); nb = 128; }
        float q[64], o[64];
        { const v4u* qp = (const v4u*)(QKV + (size_t)m * NP + qcol);
#pragma unroll
          for (int j = 0; j < 8; ++j) { const v4u w = qp[j]; q[8*j+0] = bflo(w.x); q[8*j+1] = bfhi(w.x); q[8*j+2] = bflo(w.y); q[8*j+3] = bfhi(w.y); q[8*j+4] = bflo(w.z); q[8*j+5] = bfhi(w.z); q[8*j+6] = bflo(w.w); q[8*j+7] = bfhi(w.w); } }
#pragma unroll
        for (int j = 0; j < 64; ++j) o[j] = 0.f;
        float mx = (c == 0) ? sinks[h] : -1e30f, l = (c == 0) ? 1.f : 0.f;
        const float* bt = biasT + ((c > 0 ? c - 1 : 0) * 8 + h) * BIAS_LD;
        for (int d = 0; d <= nb; ++d) {
            const int kp = pos - d * dil; if (kp < 0) break;
            const bf16* row = QKV + (size_t)(m - d * dil) * NP;
            const v4u* kr = (const v4u*)(row + kcol); float s = 0.f;
#pragma unroll
            for (int j = 0; j < 8; ++j) { const v4u w = kr[j];
                s += q[8*j+0] * bflo(w.x) + q[8*j+1] * bfhi(w.x) + q[8*j+2] * bflo(w.y) + q[8*j+3] * bfhi(w.y) + q[8*j+4] * bflo(w.z) + q[8*j+5] * bfhi(w.z) + q[8*j+6] * bflo(w.w) + q[8*j+7] * bfhi(w.w); }
            if (c) s += bt[d];
            const float mn = fmaxf(mx, s), al = __expf(mx - mn), p = __expf(s - mn);
            l = l * al + p; mx = mn;
            const v4u* vr = (const v4u*)(row + vcol);
#pragma unroll
            for (int j = 0; j < 8; ++j) { const v4u w = vr[j];
                o[8*j+0] = o[8*j+0] * al + p * bflo(w.x); o[8*j+1] = o[8*j+1] * al + p * bfhi(w.x); o[8*j+2] = o[8*j+2] * al + p * bflo(w.y); o[8*j+3] = o[8*j+3] * al + p * bfhi(w.y);
                o[8*j+4] = o[8*j+4] * al + p * bflo(w.z); o[8*j+5] = o[8*j+5] * al + p * bfhi(w.z); o[8*j+6] = o[8*j+6] * al + p * bflo(w.w); o[8*j+7] = o[8*j+7] * al + p * bfhi(w.w); }
        }
        const float inv = 1.0f / l;
        bf16* op = (c == 0) ? (OA + (size_t)m * 512 + h * 64) : (OB + (size_t)(c - 1) * M * 512 + (size_t)m * 512 + h * 64);
#pragma unroll
        for (int j = 0; j < 8; ++j) { v4u w; w.x = pk2(o[8*j+0] * inv, o[8*j+1] * inv); w.y = pk2(o[8*j+2] * inv, o[8*j+3] * inv); w.z = pk2(o[8*j+4] * inv, o[8*j+5] * inv); w.w = pk2(o[8*j+6] * inv, o[8*j+7] * inv); ((v4u*)op)[j] = w; }
        if (c) LSE[(size_t)(c - 1) * M * 8 + (size_t)m * 8 + h] = mx + logf(l);
    }
}

namespace att {
typedef short bf16x8 __attribute__((ext_vector_type(8)));
typedef short s16x4 __attribute__((ext_vector_type(4)));
typedef float f32x16 __attribute__((ext_vector_type(16)));
typedef unsigned u32x2 __attribute__((ext_vector_type(2)));
typedef short v4i16_t __attribute__((ext_vector_type(4)));
__device__ __forceinline__ int crow(int i, int hi) { return (i & 3) + 8 * (i >> 2) + 4 * hi; }
__device__ __forceinline__ s16x4 vtr(LAS const char* p) { return __builtin_bit_cast(s16x4, __builtin_amdgcn_ds_read_tr16_b64_v4i16((LAS v4i16_t*)p)); }
constexpr int CTAB_OFF = 0, CTAB_BYTES = 20480, KWIN_OFF = 20480, WIN_BYTES = 49152, VWIN_OFF = KWIN_OFF + WIN_BYTES;
constexpr float LOG2E = 1.4426950408889634f;

template <int C>
__device__ __forceinline__ void attn_wg(const bf16* QKV, bf16* Oout, float* LSEout, int b, int h, int dil, float sink, const float* bias_g  ,
                                        LAS unsigned char* ldsl, int tid, int lane, int wave) {
    constexpr int NB = C == 0 ? 127 : 128;
    const int r = lane & 31, hi = lane >> 5;
    const int qcol = C == 0 ? h * 64 : 768 + h * 64, kcol = C == 0 ? 512 + (h >> 2) * 64 : 1280 + h * 64, vcol = C == 0 ? 640 + (h >> 2) * 64 : 1792 + h * 64;
    LAS float* ctab = (LAS float*)(ldsl + CTAB_OFF);
    LAS char* kwin = (LAS char*)(ldsl + KWIN_OFF);
    LAS char* vwin = (LAS char*)(ldsl + VWIN_OFF);
    for (int idx = tid; idx < 5 * 16 * 64; idx += 512) {
        const int e = idx & 3, ln = (idx >> 2) & 63, i4 = (idx >> 8) & 3, t = idx >> 10, i = 4 * i4 + e;
        const int delta = 128 - 32 * t + (ln & 31) - crow(i, ln >> 5);
        float v = -INFINITY;
        if (delta >= 0 && delta <= NB) v = C == 0 ? 0.f : bias_g[delta];
        ctab[idx] = v;
    }
    const int upr = 32 / dil;
    const size_t seq0 = (size_t)b * SEQ;
#define ATT_DMA_K(res_, u0_) do { _Pragma("unroll") for (int j_ = 0; j_ < 6; ++j_) { const int pc_ = wave * 6 + j_; const int kt_ = 8 * (pc_ & 3) + (lane >> 3); \
        int sp_ = (u0_) - 128 + 32 * (pc_ >> 2) + kt_; sp_ = sp_ < 0 ? 0 : sp_; const int ch_ = (lane & 7) ^ ((kt_ >> 1) & 7); \
        __builtin_amdgcn_global_load_lds((const unsigned*)(QKV + (seq0 + (res_) + (size_t)dil * sp_) * NP + kcol + 8 * ch_), (LAS unsigned*)(kwin + pc_ * 1024), 16, 0, 0); } } while (0)
#define ATT_DMA_V(res_, u0_) do { _Pragma("unroll") for (int j_ = 0; j_ < 6; ++j_) { const int pc_ = wave * 6 + j_; const int jv_ = pc_ & 3; \
        int sp_ = (u0_) - 128 + 32 * (pc_ >> 2) + 16 * (jv_ & 1) + (lane >> 2); sp_ = sp_ < 0 ? 0 : sp_; \
        __builtin_amdgcn_global_load_lds((const unsigned*)(QKV + (seq0 + (res_) + (size_t)dil * sp_) * NP + vcol + 32 * (jv_ >> 1) + 8 * (lane & 3)), (LAS unsigned*)(vwin + pc_ * 1024), 16, 0, 0); } } while (0)
#define ATT_LOAD_Q(res_, u0_) do { const bf16* qp_ = QKV + (seq0 + (res_) + (size_t)dil * ((u0_) + 32 * wave + r)) * NP + qcol + 8 * hi; \
        _Pragma("unroll") for (int ks_ = 0; ks_ < 4; ++ks_) qf[ks_] = *(const bf16x8*)(qp_ + 16 * ks_); } while (0)
    bf16x8 qf[4];
    ATT_DMA_K(0, 0);
    ATT_LOAD_Q(0, 0);
    const int koff = r * 128, kx = (r >> 1) & 7;
    const int vrd = ((lane >> 4) & 1) * 32 + (lane & 3) * 8 + (4 * hi + ((lane & 15) >> 2)) * 64;
    for (int u = 0; u < 32; ++u) {
        const int res = u / upr, u0 = (u % upr) * 256;
        const int l0 = u0 + 32 * wave;
        const int t0 = l0 >= 128 ? 0 : ((128 - l0) >> 5);
        asm volatile("s_waitcnt vmcnt(0)" ::: "memory");
        __syncthreads();
        ATT_DMA_V(res, u0);
        f32x16 S[5];
#pragma unroll
        for (int t = 0; t < 5; ++t) {
            f32x16 acc;
#pragma unroll
            for (int i4 = 0; i4 < 4; ++i4) { const f32x4 cv = *(const LAS f32x4*)(ctab + ((t * 4 + i4) * 64 + lane) * 4); acc[4*i4+0] = cv[0]; acc[4*i4+1] = cv[1]; acc[4*i4+2] = cv[2]; acc[4*i4+3] = cv[3]; }
            const LAS char* kt = kwin + (wave + t) * 4096 + koff;
#pragma unroll
            for (int ks = 0; ks < 4; ++ks) { const bf16x8 kf = *(const LAS bf16x8*)(kt + (((2 * ks + hi) ^ kx) << 4)); acc = __builtin_amdgcn_mfma_f32_32x32x16_bf16(kf, qf[ks], acc, 0, 0, 0); }
            if (t < t0) {
#pragma unroll
                for (int i = 0; i < 16; ++i) acc[i] = -INFINITY;
            }
            S[t] = acc;
        }
        float mx = C == 0 ? sink : -1e30f;
#pragma unroll
        for (int t = 0; t < 5; ++t)
#pragma unroll
            for (int i = 0; i < 16; ++i) mx = fmaxf(mx, S[t][i]);
        mx = fmaxf(mx, __shfl_xor(mx, 32));
        const float mneg = -mx * LOG2E;
        float l = 0.f;
#pragma unroll
        for (int t = 0; t < 5; ++t)
#pragma unroll
            for (int i = 0; i < 16; ++i) { const float p = __builtin_amdgcn_exp2f(__builtin_fmaf(S[t][i], LOG2E, mneg)); S[t][i] = p; l += p; }
        l += __shfl_xor(l, 32);
        if (C == 0) l += __builtin_amdgcn_exp2f(__builtin_fmaf(sink, LOG2E, mneg));
        const size_t rowq = seq0 + res + (size_t)dil * (l0 + r);
        asm volatile("s_waitcnt vmcnt(0)" ::: "memory");
        __syncthreads();
        if (u + 1 < 32) { const int res1 = (u + 1) / upr, u1 = ((u + 1) % upr) * 256; ATT_DMA_K(res1, u1); ATT_LOAD_Q(res1, u1); }
        f32x16 o0 = {}, o1 = {};
#pragma unroll
        for (int t = 0; t < 5; ++t) {
            const LAS char* vb = vwin + (wave + t) * 4096 + vrd;
            bf16x8 pf[2];
#pragma unroll
            for (int s = 0; s < 2; ++s) { v4u w; w.x = pk2(S[t][8*s+0], S[t][8*s+1]); w.y = pk2(S[t][8*s+2], S[t][8*s+3]); w.z = pk2(S[t][8*s+4], S[t][8*s+5]); w.w = pk2(S[t][8*s+6], S[t][8*s+7]);
                pf[s] = __builtin_bit_cast(bf16x8, w); }
#pragma unroll
            for (int s = 0; s < 2; ++s) {
                const s16x4 a0 = vtr(vb + s * 1024), a1 = vtr(vb + s * 1024 + 512);
                const s16x4 c0 = vtr(vb + 2048 + s * 1024), c1 = vtr(vb + 2048 + s * 1024 + 512);
                const bf16x8 v0 = (bf16x8){a0[0], a0[1], a0[2], a0[3], a1[0], a1[1], a1[2], a1[3]};
                const bf16x8 v1 = (bf16x8){c0[0], c0[1], c0[2], c0[3], c1[0], c1[1], c1[2], c1[3]};
                o0 = __builtin_amdgcn_mfma_f32_32x32x16_bf16(v0, pf[s], o0, 0, 0, 0);
                o1 = __builtin_amdgcn_mfma_f32_32x32x16_bf16(v1, pf[s], o1, 0, 0, 0);
            }
        }
        const float inv = 1.0f / l;
        bf16* op = Oout + rowq * 512 + h * 64 + 4 * hi;
#pragma unroll
        for (int g = 0; g < 4; ++g) {
            u32x2 w; w.x = pk2(o0[4*g+0] * inv, o0[4*g+1] * inv); w.y = pk2(o0[4*g+2] * inv, o0[4*g+3] * inv); *(u32x2*)(op + 8 * g) = w;
            u32x2 z; z.x = pk2(o1[4*g+0] * inv, o1[4*g+1] * inv); z.y = pk2(o1[4*g+2] * inv, o1[4*g+3] * inv); *(u32x2*)(op + 32 + 8 * g) = z;
        }
        if (C == 1 && hi == 0) LSEout[rowq * 8 + h] = mx + logf(l);
    }
    asm volatile("s_waitcnt vmcnt(0)" ::: "memory");
    __syncthreads();
#undef ATT_DMA_K
#undef ATT_DMA_V
#undef ATT_LOAD_Q
}
}
__global__ void __launch_bounds__(512, 2) hymba_fwd(Args a) {
    extern __shared__ __attribute__((aligned(16))) unsigned char lds[];
    cg::grid_group grid = cg::this_grid();
    const int tid = threadIdx.x, lane = tid & 63, wave = __builtin_amdgcn_readfirstlane(tid >> 6);
    const int G = gridDim.x, bid = blockIdx.x;
    const int gw = bid * 8 + wave, NGW = G * 8, gt = bid * 512 + tid, NGT = G * 512;
    unsigned char* ws = a.ws;
    const float* x = a.in[0]; const float* g_attn = a.in[1]; const float* w_in = a.in[2]; const float* b_in = a.in[3]; const float* sinks = a.in[4];
    const float* rel_table = a.in[5]; const float* g_out_a = a.in[6]; const float* g_out_b = a.in[7]; const float* w_o = a.in[8]; const float* g_ffn = a.in[9];
    const float* w_gate = a.in[10]; const float* w_up = a.in[11]; const float* w_down = a.in[12]; const float* g_final = a.in[13];
    float* out = a.out;
    float* ssq1 = (float*)(ws + WS_SSQ1); float* biasT = (float*)(ws + WS_BIAS); float* ropeC = (float*)(ws + WS_ROPE); float* ropeS = ropeC + SEQ * 32;
    bf16* W1t = (bf16*)(ws + WS_W1); bf16* W2t = (bf16*)(ws + WS_W2); bf16* W3t = (bf16*)(ws + WS_W3); bf16* W4t = (bf16*)(ws + WS_W4);
    bf16* XN = (bf16*)(ws + WS_XN); bf16* QKV = (bf16*)(ws + WS_QKV); bf16* OA = (bf16*)(ws + WS_OA); bf16* OB = (bf16*)(ws + WS_OB);
    float* LSE = (float*)(ws + WS_LSE); bf16* X1B = (bf16*)(ws + WS_X1B); bf16* ACT = (bf16*)(ws + WS_ACT);
    LAS unsigned char* ldsl = (LAS unsigned char*)lds;
    for (int u = tid; u < 128; u += 512) ((LAS unsigned*)(ldsl + LDSCTL_OFF))[u] = 0u;
    __syncthreads();
    XcdBarrier bar = xcd_barrier_post((unsigned*)(a.ws + WS_BAR), (volatile LAS unsigned*)(ldsl + LDSCTL_OFF + 320) + 8);

    {
        LAS float* scr = (LAS float*)(ldsl + wave * 16384);
        constexpr int I1 = 16 * 72, I2 = 16 * 32, I3 = 16 * 88, I4 = 44 * 32, NIT = I1 + I2 + 2 * I3 + I4;
        for (int it = gw; it < NIT; it += NGW) {
            int r = it;
            if (r < I1) { const int kb = r / 72, nb = r % 72; tr_item<true>(w_in, DM, NP, 64 * kb, 32 * nb, W1t, 32 * nb, scr, lane, nullptr); continue; } r -= I1;
            if (r < I2) { const int kb = r / 32, nb = r % 32; tr_item<false>(w_o, DM, DM, 64 * kb, 32 * nb, W2t, 32 * nb, scr, lane, nullptr); continue; } r -= I2;
            if (r < I3) { const int kb = r / 88, nb = r % 88, n0 = 32 * nb; tr_item<false>(w_gate, DM, FF, 64 * kb, n0, W3t, 256 * (n0 >> 7) + (n0 & 127), scr, lane, g_ffn); continue; } r -= I3;
            if (r < I3) { const int kb = r / 88, nb = r % 88, n0 = 32 * nb; tr_item<false>(w_up, DM, FF, 64 * kb, n0, W3t, 256 * (n0 >> 7) + 128 + (n0 & 127), scr, lane, g_ffn); continue; } r -= I3;
            { const int kb = r / 32, nb = r % 32; tr_item<false>(w_down, FF, DM, 64 * kb, 32 * nb, W4t, 32 * nb, scr, lane, nullptr); }
        }
        for (int m0 = gw * 4; m0 < M; m0 += NGW * 4) {
            f32x4 v[4][4]; float s[4];
#pragma unroll
            for (int q = 0; q < 4; ++q) { const f32x4* xr = (const f32x4*)(x + (size_t)(m0 + q) * DM) + lane;
#pragma unroll
                for (int j = 0; j < 4; ++j) v[q][j] = xr[64 * j]; }
            f32x4 g[4];
#pragma unroll
            for (int j = 0; j < 4; ++j) g[j] = ((const f32x4*)g_attn)[lane + 64 * j];
#pragma unroll
            for (int q = 0; q < 4; ++q) { float t = 0.f;
#pragma unroll
                for (int j = 0; j < 4; ++j) t += (v[q][j].x * v[q][j].x + v[q][j].y * v[q][j].y) + (v[q][j].z * v[q][j].z + v[q][j].w * v[q][j].w);
                s[q] = t; }
#pragma unroll
            for (int o = 1; o < 64; o <<= 1) {
#pragma unroll
                for (int q = 0; q < 4; ++q) s[q] += __shfl_xor(s[q], o); }
#pragma unroll
            for (int q = 0; q < 4; ++q) { const float rs = 1.0f / sqrtf(s[q] * (1.0f / DM) + EPS);
                unsigned long long* o8 = (unsigned long long*)(XN + (size_t)(m0 + q) * DM) + lane;
#pragma unroll
                for (int j = 0; j < 4; ++j) o8[64 * j] = (unsigned long long)pk2(v[q][j].x * rs * g[j].x, v[q][j].y * rs * g[j].y) | ((unsigned long long)pk2(v[q][j].z * rs * g[j].z, v[q][j].w * rs * g[j].w) << 32); }
        }
        for (int i = gt; i < SEQ * 32; i += NGT) { const int pos = i >> 5, f = i & 31;
            const float inv_freq = (float)exp2(-(double)f * (17.194602975157967 / 32.0));
            const float ang = (float)pos * inv_freq;
            double rev = (double)ang * 0.15915494309189535; rev -= rint(rev);
            ropeC[i] = __builtin_amdgcn_cosf((float)rev); ropeS[i] = __builtin_amdgcn_sinf((float)rev); }
        for (int i = gt; i < 3 * 8 * 129; i += NGT) { const int d = i % 129, bh = i / 129, h = bh & 7, br = bh >> 3; const int dil = br == 0 ? 1 : (br == 1 ? 4 : 16);
            biasT[bh * BIAS_LD + d] = rel_table[t5_bucket(d * dil) * 8 + h]; }
        for (int i = gt; i < M; i += NGT) ssq1[i] = 0.f;
    }
    grid.sync();
    { pg8::Gemm g{XN, W1t, M, NP, DM}; pg8::StaticOrder S; S.init(M, NP, G, bid); pg8::EpiQKV E{QKV, b_in, ropeC, ropeS};
      pg8::gemm_phase<pg8::EpiQKV, pg8::StaticOrder, true, true>(ldsl, g, S, E); }
#if defined(REP_G1)
    { pg8::Gemm g{XN, W1t, M, NP, DM}; pg8::StaticOrder S; S.init(M, NP, G, bid); pg8::EpiQKV E{QKV, b_in, ropeC, ropeS};
      pg8::gemm_phase<pg8::EpiQKV, pg8::StaticOrder, true, true>(ldsl, g, S, E); }
#endif
    xcd_barrier(bar);
#ifdef NAIVE_ATTN
    naive_attn(QKV, OA, OB, LSE, sinks, biasT, gt, NGT);
#else
    for (int wg = bid; wg < 256; wg += G) {
        const int c = wg >> 6, b = (wg >> 3) & 7, h = wg & 7;
        if (c == 0) att::attn_wg<0>(QKV, OA, nullptr, b, h, 1, sinks[h], biasT, ldsl, tid, lane, wave);
        else att::attn_wg<1>(QKV, OB + (size_t)(c - 1) * M * 512, LSE + (size_t)(c - 1) * M * 8, b, h, c == 1 ? 1 : (c == 2 ? 4 : 16), 0.f, biasT + ((c - 1) * 8 + h) * BIAS_LD, ldsl, tid, lane, wave);
    }
#endif
#if defined(REP_ATT)
#ifdef NAIVE_ATTN
    naive_attn(QKV, OA, OB, LSE, sinks, biasT, gt, NGT);
#else
    for (int wg = bid; wg < 256; wg += G) {
        const int c = wg >> 6, b = (wg >> 3) & 7, h = wg & 7;
        if (c == 0) att::attn_wg<0>(QKV, OA, nullptr, b, h, 1, sinks[h], biasT, ldsl, tid, lane, wave);
        else att::attn_wg<1>(QKV, OB + (size_t)(c - 1) * M * 512, LSE + (size_t)(c - 1) * M * 8, b, h, c == 1 ? 1 : (c == 2 ? 4 : 16), 0.f, biasT + ((c - 1) * 8 + h) * BIAS_LD, ldsl, tid, lane, wave);
    }
#endif
#endif
    xcd_barrier(bar);
    for (int m0 = gw * 4; m0 < M; m0 += NGW * 4) {
        v4u ra[4][2], rb[4][3][2]; float ls[4][3];
        const int cb = (lane & 31) * 16, hh = cb >> 6;
#pragma unroll
        for (int q = 0; q < 4; ++q) { const size_t m = (size_t)(m0 + q);
            if (lane < 32) { const v4u* p = (const v4u*)(OA + m * 512 + cb); ra[q][0] = p[0]; ra[q][1] = p[1]; }
            else {
#pragma unroll
                for (int br = 0; br < 3; ++br) { const v4u* p = (const v4u*)(OB + (size_t)br * M * 512 + m * 512 + cb); rb[q][br][0] = p[0]; rb[q][br][1] = p[1]; ls[q][br] = LSE[(size_t)br * M * 8 + m * 8 + hh]; } } }
        const float* gp = (lane < 32) ? (g_out_a + cb) : (g_out_b + cb);
        float gg[16];
#pragma unroll
        for (int j = 0; j < 4; ++j) { const f32x4 t = ((const f32x4*)gp)[j]; gg[4*j] = t.x; gg[4*j+1] = t.y; gg[4*j+2] = t.z; gg[4*j+3] = t.w; }
#pragma unroll
        for (int q = 0; q < 4; ++q) {
            float v[16];
            if (lane < 32) {
#pragma unroll
                for (int j = 0; j < 2; ++j) { const v4u w = ra[q][j]; v[8*j+0] = bflo(w.x); v[8*j+1] = bfhi(w.x); v[8*j+2] = bflo(w.y); v[8*j+3] = bfhi(w.y); v[8*j+4] = bflo(w.z); v[8*j+5] = bfhi(w.z); v[8*j+6] = bflo(w.w); v[8*j+7] = bfhi(w.w); }
            } else {
                const float l1 = ls[q][0], l2 = ls[q][1], l3 = ls[q][2];
                const float mxl = fmaxf(l1, fmaxf(l2, l3)); float w1 = __expf(l1 - mxl), w2 = __expf(l2 - mxl), w3 = __expf(l3 - mxl); const float wi = 1.0f / (w1 + w2 + w3); w1 *= wi; w2 *= wi; w3 *= wi;
#pragma unroll
                for (int j = 0; j < 16; ++j) v[j] = 0.f;
#pragma unroll
                for (int br = 0; br < 3; ++br) { const float wb = br == 0 ? w1 : (br == 1 ? w2 : w3);
#pragma unroll
                    for (int j = 0; j < 2; ++j) { const v4u w = rb[q][br][j]; v[8*j+0] += wb * bflo(w.x); v[8*j+1] += wb * bfhi(w.x); v[8*j+2] += wb * bflo(w.y); v[8*j+3] += wb * bfhi(w.y); v[8*j+4] += wb * bflo(w.z); v[8*j+5] += wb * bfhi(w.z); v[8*j+6] += wb * bflo(w.w); v[8*j+7] += wb * bfhi(w.w); } }
            }
            float ss = 0.f;
#pragma unroll
            for (int j = 0; j < 16; ++j) ss += v[j] * v[j];
#pragma unroll
            for (int o = 1; o < 32; o <<= 1) ss += __shfl_xor(ss, o);
            const float rs = 1.0f / sqrtf(ss * (1.0f / 512.0f) + EPS);
            v4u w0, w1v;
            w0.x = pk2(v[0] * rs * gg[0], v[1] * rs * gg[1]); w0.y = pk2(v[2] * rs * gg[2], v[3] * rs * gg[3]); w0.z = pk2(v[4] * rs * gg[4], v[5] * rs * gg[5]); w0.w = pk2(v[6] * rs * gg[6], v[7] * rs * gg[7]);
            w1v.x = pk2(v[8] * rs * gg[8], v[9] * rs * gg[9]); w1v.y = pk2(v[10] * rs * gg[10], v[11] * rs * gg[11]); w1v.z = pk2(v[12] * rs * gg[12], v[13] * rs * gg[13]); w1v.w = pk2(v[14] * rs * gg[14], v[15] * rs * gg[15]);
            v4u* op = (v4u*)(XN + (size_t)(m0 + q) * DM + lane * 16); op[0] = w0; op[1] = w1v;
        }
    }
    xcd_barrier(bar);
    { pg8::Gemm g{XN, W2t, M, DM, DM}; pg8::StaticOrder S; S.init(M, DM, G, bid); pg8::EpiRes1 E{x, out, X1B, ssq1};
      pg8::gemm_phase<pg8::EpiRes1, pg8::StaticOrder, true, true>(ldsl, g, S, E); }
    xcd_barrier(bar);
    { pg8::Gemm g{X1B, W3t, M, NGU, DM}; pg8::StaticOrder S; S.init(M, NGU, G, bid); pg8::EpiSwiGLU E{ACT, ssq1};
      pg8::gemm_phase<pg8::EpiSwiGLU, pg8::StaticOrder, true, true>(ldsl, g, S, E); }
#if defined(REP_G3)
    { pg8::Gemm g{X1B, W3t, M, NGU, DM}; pg8::StaticOrder S; S.init(M, NGU, G, bid); pg8::EpiSwiGLU E{ACT, ssq1};
      pg8::gemm_phase<pg8::EpiSwiGLU, pg8::StaticOrder, true, true>(ldsl, g, S, E); }
#endif
    xcd_barrier(bar);
    { pg8::Gemm g{ACT, W4t, M, DM, FF}; pg8::StaticOrder S; S.init(M, DM, G, bid); pg8::EpiRes2 E{out};
      pg8::gemm_phase<pg8::EpiRes2, pg8::StaticOrder, true, true>(ldsl, g, S, E); }
    xcd_barrier(bar);
    for (int m0 = gw * 4; m0 < M; m0 += NGW * 4) {
        f32x4 v[4][4]; float s[4];
#pragma unroll
        for (int q = 0; q < 4; ++q) { const f32x4* xr = (const f32x4*)(out + (size_t)(m0 + q) * DM) + lane;
#pragma unroll
            for (int j = 0; j < 4; ++j) v[q][j] = xr[64 * j]; }
        f32x4 g[4];
#pragma unroll
        for (int j = 0; j < 4; ++j) g[j] = ((const f32x4*)g_final)[lane + 64 * j];
#pragma unroll
        for (int q = 0; q < 4; ++q) { float t = 0.f;
#pragma unroll
            for (int j = 0; j < 4; ++j) t += (v[q][j].x * v[q][j].x + v[q][j].y * v[q][j].y) + (v[q][j].z * v[q][j].z + v[q][j].w * v[q][j].w);
            s[q] = t; }
#pragma unroll
        for (int o = 1; o < 64; o <<= 1) {
#pragma unroll
            for (int q = 0; q < 4; ++q) s[q] += __shfl_xor(s[q], o); }
#pragma unroll
        for (int q = 0; q < 4; ++q) { const float rs = 1.0f / sqrtf(s[q] * (1.0f / DM) + EPS); f32x4* xr = (f32x4*)(out + (size_t)(m0 + q) * DM) + lane;
#pragma unroll
            for (int j = 0; j < 4; ++j) xr[64 * j] = v[q][j] * rs * g[j]; }
    }
}

extern "C" void kernel_launch(void* const* d_in, const int* in_sizes, int n_in, void* d_out, int out_size, void* d_ws, size_t ws_size, hipStream_t stream) {
    static int grid = 0;
    if (grid == 0) {
        if (n_in != 14 || out_size != M * DM || ws_size < WS_END) { fprintf(stderr, "kernel_launch: unexpected shapes (n_in %d out %d ws %zu)\n", n_in, out_size, ws_size); grid = -1; return; }
        int dev = 0, cus = 0, per_cu = 0;
        hipGetDevice(&dev); hipDeviceGetAttribute(&cus, hipDeviceAttributeMultiprocessorCount, dev);
        hipFuncSetAttribute((const void*)hymba_fwd, hipFuncAttributeMaxDynamicSharedMemorySize, LDS_BYTES);
        hipOccupancyMaxActiveBlocksPerMultiprocessor(&per_cu, (const void*)hymba_fwd, 512, LDS_BYTES);
        if (per_cu < 1) { fprintf(stderr, "kernel_launch: occupancy query says %d blocks per CU\n", per_cu); per_cu = 1; }
        (void)hipGetLastError();
        grid = cus * 1;
    }
    if (grid < 0) return;
    if (hipMemsetAsync((char*)d_ws + WS_BAR, 0, 16384, stream) != hipSuccess) { fprintf(stderr, "kernel_launch: memset failed\n"); return; }
    Args a{};
    for (int i = 0; i < 14; ++i) a.in[i] = (const float*)d_in[i];
    a.out = (float*)d_out; a.ws = (unsigned char*)d_ws;
    void* args[] = {&a};
    hipError_t e = hipLaunchCooperativeKernel((const void*)hymba_fwd, dim3(grid), dim3(512), args, LDS_BYTES, stream);
    if (e != hipSuccess) fprintf(stderr, "cooperative launch failed: %s (grid %d)\n", hipGetErrorString(e), grid);
}
```
